# Optimizing an MI355X kernel written in HIP

```python
import jax, jax.numpy as jnp
from jax import lax
import numpy as np

D_MODEL = 2048
BATCH = 4
SEQ = 4096
DEPTH = 2

N_MIXERS = 2
N_MLA_LAYERS = (DEPTH + 1) // 2
N_CONV_LAYERS = DEPTH // 2
MLA_HEADS = 16
QK_NOPE_DIM = 128
QK_ROPE_DIM = 64
V_HEAD_DIM = 128
Q_LORA_RANK = 512
KV_LORA_RANK = 512
MLA_LATENT_DIM = Q_LORA_RANK + KV_LORA_RANK + QK_ROPE_DIM
ROPE_THETA = 10000.0
CONV_WIDTH = 3
D_FF = 4 * D_MODEL
Q_BLOCK = 128
NORM_EPS = 1e-6
N_MOD = 6

kernel_name = "hybrid_mla_shortconv_adaln_sandwich"


def rmsnorm(x, g):
    x32 = x.astype(jnp.float32)
    y = x32 * lax.rsqrt(jnp.mean(x32 * x32, axis=-1, keepdims=True) + NORM_EPS)
    return (y * g.astype(jnp.float32)).astype(x.dtype)


def rope_cos_sin(positions):
    inv_freq = ROPE_THETA ** (-jnp.arange(0, QK_ROPE_DIM, 2, dtype=jnp.float32) / QK_ROPE_DIM)
    ang = positions.astype(jnp.float32)[..., None] * inv_freq
    return jnp.cos(ang), jnp.sin(ang)


def apply_rope(t, cos, sin):
    t32 = t.astype(jnp.float32)
    half = QK_ROPE_DIM // 2
    t1, t2 = t32[..., :half], t32[..., half:]
    out = jnp.concatenate([t1 * cos - t2 * sin, t2 * cos + t1 * sin], axis=-1)
    return out.astype(t.dtype)


def mla_mixer(h, positions, w_in, g_q, g_kv, w_uq, w_ukv, w_o):
    B, S, _ = h.shape
    lat = h @ w_in
    c_q = rmsnorm(lat[..., :Q_LORA_RANK], g_q)
    c_kv = rmsnorm(lat[..., Q_LORA_RANK:Q_LORA_RANK + KV_LORA_RANK], g_kv)
    k_rope = lat[..., Q_LORA_RANK + KV_LORA_RANK:]
    cos, sin = rope_cos_sin(positions)
    k_rope = apply_rope(k_rope, cos, sin)
    q = jnp.einsum('bsr,rhd->bshd', c_q, w_uq)
    q_nope = q[..., :QK_NOPE_DIM]
    q_rope = apply_rope(q[..., QK_NOPE_DIM:], cos[:, :, None, :], sin[:, :, None, :])
    kv = jnp.einsum('bsr,rhd->bshd', c_kv, w_ukv)
    k_nope, v = kv[..., :QK_NOPE_DIM], kv[..., QK_NOPE_DIM:]

    n_blk = S // Q_BLOCK
    scale = (QK_NOPE_DIM + QK_ROPE_DIM) ** -0.5
    qn_blocks = q_nope.reshape(B, n_blk, Q_BLOCK, MLA_HEADS, QK_NOPE_DIM).transpose(1, 0, 2, 3, 4)
    qr_blocks = q_rope.reshape(B, n_blk, Q_BLOCK, MLA_HEADS, QK_ROPE_DIM).transpose(1, 0, 2, 3, 4)
    starts = jnp.arange(n_blk, dtype=jnp.int32) * Q_BLOCK
    k_idx = jnp.arange(S, dtype=jnp.int32)

    def attend(args):
        qn, qr, start = args
        s = (jnp.einsum('bqhd,bkhd->bhqk', qn, k_nope, preferred_element_type=jnp.float32)
             + jnp.einsum('bqhd,bkd->bhqk', qr, k_rope, preferred_element_type=jnp.float32)) * scale
        q_idx = start + jnp.arange(Q_BLOCK, dtype=jnp.int32)
        causal = k_idx[None, :] <= q_idx[:, None]
        s = jnp.where(causal, s, jnp.finfo(jnp.float32).min)
        p = jax.nn.softmax(s, axis=-1)
        return jnp.einsum('bhqk,bkhd->bqhd', p.astype(v.dtype), v)

    o = lax.map(attend, (qn_blocks, qr_blocks, starts))
    o = o.transpose(1, 0, 2, 3, 4).reshape(B, S, MLA_HEADS * V_HEAD_DIM)
    return o @ w_o


def short_conv_mixer(h, w_in, conv_w, w_out):
    proj = h @ w_in
    b_gate = proj[..., :D_MODEL]
    c_gate = proj[..., D_MODEL:2 * D_MODEL]
    u = proj[..., 2 * D_MODEL:]
    z = c_gate * u
    z = lax.conv_general_dilated(z, conv_w[:, None, :].astype(z.dtype), window_strides=(1,),
                                 padding=[(CONV_WIDTH - 1, 0)],
                                 dimension_numbers=('NWC', 'WIO', 'NWC'),
                                 feature_group_count=D_MODEL)
    return (b_gate * z) @ w_out


def sq_relu_mlp(h, w_up, w_down):
    a = jax.nn.relu(h @ w_up)
    return (a * a) @ w_down


def setup_inputs(seed: int = 0) -> dict:
    key = jax.random.key(seed)
    ks = jax.random.split(key, 20)
    f32 = jnp.float32

    def nrm(k, shape, fan_in, mult=1.0):
        return jax.random.normal(k, shape, f32) * (mult * fan_in ** -0.5)

    x = jax.random.normal(ks[0], (BATCH, SEQ, D_MODEL), f32)
    c = jax.random.normal(ks[1], (BATCH, D_MODEL), f32)
    offsets = jax.random.randint(ks[2], (BATCH, 1), 0, 1024, dtype=jnp.int32)
    positions = jnp.arange(SEQ, dtype=jnp.int32)[None, :] + offsets
    w_mod = nrm(ks[3], (DEPTH, D_MODEL, N_MOD * D_MODEL), D_MODEL, 0.5)
    b_mod = 0.02 * jax.random.normal(ks[4], (DEPTH, N_MOD * D_MODEL), f32)
    norm_g = 1.0 + 0.05 * jax.random.normal(ks[5], (DEPTH, 4, D_MODEL), f32)
    mla_w_in = nrm(ks[6], (N_MLA_LAYERS, D_MODEL, MLA_LATENT_DIM), D_MODEL)
    mla_g_q = 1.0 + 0.05 * jax.random.normal(ks[7], (N_MLA_LAYERS, Q_LORA_RANK), f32)
    mla_g_kv = 1.0 + 0.05 * jax.random.normal(ks[8], (N_MLA_LAYERS, KV_LORA_RANK), f32)
    mla_w_uq = nrm(ks[9], (N_MLA_LAYERS, Q_LORA_RANK, MLA_HEADS, QK_NOPE_DIM + QK_ROPE_DIM), Q_LORA_RANK)
    mla_w_ukv = nrm(ks[10], (N_MLA_LAYERS, KV_LORA_RANK, MLA_HEADS, QK_NOPE_DIM + V_HEAD_DIM), KV_LORA_RANK)
    mla_w_o = nrm(ks[11], (N_MLA_LAYERS, MLA_HEADS * V_HEAD_DIM, D_MODEL), MLA_HEADS * V_HEAD_DIM)
    conv_w_in = nrm(ks[12], (N_CONV_LAYERS, D_MODEL, 3 * D_MODEL), D_MODEL)
    conv_w = nrm(ks[13], (N_CONV_LAYERS, CONV_WIDTH, D_MODEL), CONV_WIDTH)
    conv_w_out = nrm(ks[14], (N_CONV_LAYERS, D_MODEL, D_MODEL), D_MODEL)
    mlp_w_up = nrm(ks[15], (DEPTH, D_MODEL, D_FF), D_MODEL)
    mlp_w_down = nrm(ks[16], (DEPTH, D_FF, D_MODEL), D_FF)
    return {"x": x, "c": c, "positions": positions, "w_mod": w_mod, "b_mod": b_mod,
            "norm_g": norm_g, "mla_w_in": mla_w_in, "mla_g_q": mla_g_q, "mla_g_kv": mla_g_kv,
            "mla_w_uq": mla_w_uq, "mla_w_ukv": mla_w_ukv, "mla_w_o": mla_w_o,
            "conv_w_in": conv_w_in, "conv_w": conv_w, "conv_w_out": conv_w_out,
            "mlp_w_up": mlp_w_up, "mlp_w_down": mlp_w_down}


def reference(x, c, positions, w_mod, b_mod, norm_g, mla_w_in, mla_g_q, mla_g_kv,
              mla_w_uq, mla_w_ukv, mla_w_o, conv_w_in, conv_w, conv_w_out,
              mlp_w_up, mlp_w_down):
    cond = jax.nn.silu(c)
    for i in range(DEPTH):
        mod = (cond @ w_mod[i] + b_mod[i])[:, None, :]
        sh1, sc1, g1, sh2, sc2, g2 = jnp.split(mod, N_MOD, axis=-1)
        h = rmsnorm(x, norm_g[i, 0]) * (1.0 + sc1) + sh1
        j = i // N_MIXERS
        if i % N_MIXERS == 0:
            y = mla_mixer(h, positions, mla_w_in[j], mla_g_q[j], mla_g_kv[j],
                          mla_w_uq[j], mla_w_ukv[j], mla_w_o[j])
        else:
            y = short_conv_mixer(h, conv_w_in[j], conv_w[j], conv_w_out[j])
        x = x + g1 * rmsnorm(y, norm_g[i, 1])
        h = rmsnorm(x, norm_g[i, 2]) * (1.0 + sc2) + sh2
        y = sq_relu_mlp(h, mlp_w_up[i], mlp_w_down[i])
        x = x + g2 * rmsnorm(y, norm_g[i, 3])
    return x
```

```cpp
#include <hip/hip_runtime.h>
#include <hip/hip_cooperative_groups.h>
#include <cstdio>
#include <cstdint>
namespace cg = cooperative_groups;
namespace pg8 {
#define PG8_LAS __attribute__((address_space(3)))
typedef unsigned short bf16_t;
typedef short bf16x8 __attribute__((ext_vector_type(8)));
typedef float f32x4 __attribute__((ext_vector_type(4)));
typedef unsigned u32x4 __attribute__((ext_vector_type(4)));
constexpr int BM = 256, BK = 64, HALF = 128, HTB = HALF * BK * 2  , STAGE_BYTES = 8 * HTB, NXCD = 8, WGM = 8;

__host__ __device__ __forceinline__ int lds_byte(int r, int c) { const int st = (r >> 4) * 2 + (c >> 5), rr = r & 15, cc = c & 31, ob = rr * 64 + cc * 2; return st * 1024 + (ob ^ (((ob >> 9) & 1) << 5)); }
__host__ __device__ __forceinline__ void stage_rc(int b, int& R, int& C) { const int st = b / 1024, sb = b % 1024, swz = sb ^ (((sb >> 9) & 1) << 5); R = (st >> 1) * 16 + swz / 64; C = (st & 1) * 32 + (swz % 64) / 2; }
__host__ __device__ __forceinline__ int perm32(int rho) { const int n = rho >> 4, i = rho & 15; return 8 * (i >> 2) + 4 * n + (i & 3); }

struct Unit { int pm, pn; };
struct Gemm { const bf16_t* A; const bf16_t* Bt; int M, N, K; };

struct StaticOrder {
    int nM, nN, nwg, G, c;
    __host__ __device__ void init(int M, int N, int G_, int c_) { nM = M / BM; nN = N / BM; nwg = nM * nN; G = G_; c = c_; }
    __host__ __device__ bool next(int i, Unit& u) const {
        const long L = (long)i * G + c; if (L >= nwg) return false;
        int wgid = (int)L; { const int q = nwg / NXCD, r = nwg % NXCD, xcd = wgid % NXCD, off = wgid / NXCD; wgid = (xcd < r ? xcd * (q + 1) : r * (q + 1) + (xcd - r) * q) + off; }
        const int nig = WGM * nN, gid = wgid / nig, fm = gid * WGM, gsz = (nM - fm) < WGM ? (nM - fm) : WGM;
        u.pm = fm + ((wgid % nig) % gsz); u.pn = (wgid % nig) / gsz; return true;
    }
    __device__ __forceinline__ void a_ready(const Unit&) const {}
    __device__ __forceinline__ void done(const Unit&) const {}
};


__device__ __forceinline__ unsigned cvt_pk_bf16(float lo, float hi) { unsigned r; asm volatile("v_cvt_pk_bf16_f32 %0, %1, %2" : "=v"(r) : "v"(lo), "v"(hi)); return r; }

#define PG8_GAS __attribute__((address_space(1)))
struct EpiGen {
    static constexpr bool PERM = true, AFTER_DRAIN = false;
    int mode;
    void* O; int ldc; void* O2; const float* cs; float scale;
    __device__ __forceinline__ void operator()(const f32x4 (&acc)[2][2][4][2], const Unit& u, int wr, int wc, int fr, int fq) const {
        int row0 = u.pm * BM + wr * 64 + fr;
        int colb = u.pn * BM + wc * 32 + 8 * fq;
        asm volatile("" : "+v"(row0), "+v"(colb));
        int mode = this->mode; asm volatile("" : "+s"(mode));
        if (mode == 0) {
            float* base = (float*)O;
#pragma unroll
            for (int ai = 0; ai < 2; ++ai)
#pragma unroll
                for (int m = 0; m < 4; ++m) { float* rowp = base + (size_t)(row0 + ai * HALF + m * 16) * ldc + colb;
#pragma unroll
                    for (int bj = 0; bj < 2; ++bj) { *(PG8_GAS f32x4*)(rowp + bj * HALF) = acc[ai][bj][m][0]; *(PG8_GAS f32x4*)(rowp + bj * HALF + 4) = acc[ai][bj][m][1]; } }
        } else if (mode == 5 && u.pn < 16) {
            bf16_t* base = (bf16_t*)O; const int zc = u.pn * HALF + (colb & 127);
#pragma unroll
            for (int ai = 0; ai < 2; ++ai)
#pragma unroll
                for (int m = 0; m < 4; ++m) { const f32x4 v0 = acc[ai][0][m][0] * acc[ai][1][m][0], v1 = acc[ai][0][m][1] * acc[ai][1][m][1];
                    u32x4 w; w.x = cvt_pk_bf16(v0[0], v0[1]); w.y = cvt_pk_bf16(v0[2], v0[3]); w.z = cvt_pk_bf16(v1[0], v1[1]); w.w = cvt_pk_bf16(v1[2], v1[3]);
                    *(PG8_GAS u32x4*)(base + (size_t)(row0 + ai * HALF + m * 16) * ldc + zc) = w; }
        } else if (mode == 1 || mode == 2 || mode == 5) {
            bf16_t* base = (mode == 5) ? (bf16_t*)O2 - 16 * BM : (bf16_t*)O; const bool sq = (mode == 2);
#pragma unroll
            for (int ai = 0; ai < 2; ++ai)
#pragma unroll
                for (int m = 0; m < 4; ++m) { bf16_t* rowp = base + (size_t)(row0 + ai * HALF + m * 16) * ldc + colb;
#pragma unroll
                    for (int bj = 0; bj < 2; ++bj) { f32x4 v0 = acc[ai][bj][m][0], v1 = acc[ai][bj][m][1];
                        if (sq) {
#pragma unroll
                            for (int e = 0; e < 4; ++e) { const float a = fmaxf(v0[e], 0.f), b = fmaxf(v1[e], 0.f); v0[e] = a * a; v1[e] = b * b; } }
                        u32x4 w; w.x = cvt_pk_bf16(v0[0], v0[1]); w.y = cvt_pk_bf16(v0[2], v0[3]); w.z = cvt_pk_bf16(v1[0], v1[1]); w.w = cvt_pk_bf16(v1[2], v1[3]);
                        *(PG8_GAS u32x4*)(rowp + bj * HALF) = w; } }
        } else if (mode == 3) {
            bf16_t* base = (bf16_t*)O;
#pragma unroll
            for (int bj = 0; bj < 2; ++bj) {
                const int col = colb + bj * HALF, d = col % 192; const bool rope = d >= 128; const int j0 = (d - 128) >> 1;
#pragma unroll
                for (int ai = 0; ai < 2; ++ai)
#pragma unroll
                    for (int m = 0; m < 4; ++m) { const int row = row0 + ai * HALF + m * 16;
                        f32x4 v0 = acc[ai][bj][m][0] * scale, v1 = acc[ai][bj][m][1] * scale;
                        if (rope) { const f32x4 c0 = *(const PG8_GAS f32x4*)(cs + (size_t)row * 64 + 2 * j0), c1 = *(const PG8_GAS f32x4*)(cs + (size_t)row * 64 + 2 * j0 + 4);
                            f32x4 t0, t1;
                            t0[0] = v0[0] * c0[0] - v0[1] * c0[1]; t0[1] = v0[1] * c0[0] + v0[0] * c0[1];
                            t0[2] = v0[2] * c0[2] - v0[3] * c0[3]; t0[3] = v0[3] * c0[2] + v0[2] * c0[3];
                            t1[0] = v1[0] * c1[0] - v1[1] * c1[1]; t1[1] = v1[1] * c1[0] + v1[0] * c1[1];
                            t1[2] = v1[2] * c1[2] - v1[3] * c1[3]; t1[3] = v1[3] * c1[2] + v1[2] * c1[3];
                            v0 = t0; v1 = t1; }
                        u32x4 w; w.x = cvt_pk_bf16(v0[0], v0[1]); w.y = cvt_pk_bf16(v0[2], v0[3]); w.z = cvt_pk_bf16(v1[0], v1[1]); w.w = cvt_pk_bf16(v1[2], v1[3]);
                        *(PG8_GAS u32x4*)(base + (size_t)row * ldc + col) = w; } }
        } else {
            bf16_t* kb = (bf16_t*)O; bf16_t* vb = (bf16_t*)O2; const int h = u.pn, dcol = colb & 127;
#pragma unroll
            for (int ai = 0; ai < 2; ++ai)
#pragma unroll
                for (int m = 0; m < 4; ++m) { const size_t row = (size_t)(row0 + ai * HALF + m * 16);
#pragma unroll
                    for (int bj = 0; bj < 2; ++bj) { const f32x4 v0 = acc[ai][bj][m][0], v1 = acc[ai][bj][m][1];
                        u32x4 w; w.x = cvt_pk_bf16(v0[0], v0[1]); w.y = cvt_pk_bf16(v0[2], v0[3]); w.z = cvt_pk_bf16(v1[0], v1[1]); w.w = cvt_pk_bf16(v1[2], v1[3]);
                        if (bj == 0) *(PG8_GAS u32x4*)(kb + (row * 16 + h) * 192 + dcol) = w; else *(PG8_GAS u32x4*)(vb + row * 2048 + h * 128 + dcol) = w; } }
        }
    }
};

template <class Epi, class Sched, bool ALIGN_EPI = false, bool SP2 = false>
__device__ __forceinline__ void gemm_phase(PG8_LAS unsigned char* lds, const Gemm g, const Sched& S, const Epi& E, const int tid) {
    const int wid = __builtin_amdgcn_readfirstlane(tid >> 6), lane = tid & 63, wr = wid >> 2, wc = wid & 3, fr = lane & 15, fq = lane >> 4;
    const int K = g.K, nt = K / BK;
    unsigned voffA[2], voffB[2];
#pragma unroll
    for (int i = 0; i < 2; ++i) { int R, C; stage_rc(tid * 16 + i * 8192, R, C); const int Rb = Epi::PERM ? ((R & ~31) + perm32(R & 31)) : R;
        voffA[i] = (unsigned)(R * K + C) * 2u; voffB[i] = (unsigned)(Rb * K + C) * 2u; }
    const size_t kstep = (size_t)(BK * 2);
    const size_t hstep = (size_t)HALF * K * 2;
    const size_t tstep = 2 * hstep;
    const unsigned ldsw = (unsigned)wid * 1024u;
    const int aoff = lds_byte(wr * 64 + fr, fq * 8), boff = lds_byte(wc * 32 + fr, fq * 8);
#define PG8_SA(b, h) (((b) * 2 + (h)) * HTB)
#define PG8_SB(b, h) ((4 + (b) * 2 + (h)) * HTB)
#define PG8_STAGE(bufoff, gbase, voff) do { _Pragma("unroll") for (int _i = 0; _i < 2; ++_i) \
        __builtin_amdgcn_global_load_lds((const unsigned*)((const char*)(gbase) + (voff)[_i]), (PG8_LAS unsigned*)(lds + (bufoff) + ldsw + _i * 8192), 16, 0, 0); } while (0)
#define PG8_LDA(dst, b, h) do { _Pragma("unroll") for (int m = 0; m < 4; ++m) _Pragma("unroll") for (int k = 0; k < 2; ++k) dst[m][k] = *(const PG8_LAS bf16x8*)(lds + PG8_SA(b, h) + aoff + m * 2048 + k * 1024); } while (0)
#define PG8_LDB(dst, b, h) do { _Pragma("unroll") for (int n = 0; n < 2; ++n) _Pragma("unroll") for (int k = 0; k < 2; ++k) dst[n][k] = *(const PG8_LAS bf16x8*)(lds + PG8_SB(b, h) + boff + n * 2048 + k * 1024); } while (0)
#define PG8_MMA(ai, bj, At, Bt) do { __builtin_amdgcn_s_setprio(1); _Pragma("unroll") for (int m = 0; m < 4; ++m) _Pragma("unroll") for (int n = 0; n < 2; ++n) _Pragma("unroll") for (int k = 0; k < 2; ++k) \
        acc[ai][bj][m][n] = __builtin_amdgcn_mfma_f32_16x16x32_bf16(Bt[n][k], At[m][k], acc[ai][bj][m][n], 0, 0, 0); __builtin_amdgcn_s_setprio(0); } while (0)
#define PG8_WAIT_V(n) asm volatile("s_waitcnt vmcnt(" #n ")" ::: "memory")
#define PG8_WAIT_L(n) asm volatile("s_waitcnt lgkmcnt(" #n ")" ::: "memory")
#define PG8_BAR __builtin_amdgcn_s_barrier()
#define PG8_SCHED __builtin_amdgcn_sched_barrier(0)
    Unit cur, nxt; int ui = 0;
    if (!S.next(0, cur)) return;
    f32x4 acc[2][2][4][2];
#pragma unroll
    for (int a = 0; a < 2; ++a)
#pragma unroll
        for (int b = 0; b < 2; ++b)
#pragma unroll
            for (int m = 0; m < 4; ++m)
#pragma unroll
                for (int n = 0; n < 2; ++n) acc[a][b][m][n] = (f32x4){0.f, 0.f, 0.f, 0.f};
    bf16x8 At[4][2], B0[2][2], B1[2][2];
    const char* cA = (const char*)g.A + (size_t)cur.pm * tstep; const char* cB = (const char*)g.Bt + (size_t)cur.pn * tstep;
    S.a_ready(cur);
    if constexpr (SP2) {
        PG8_STAGE(PG8_SB(0, 0), cB, voffB); PG8_STAGE(PG8_SB(0, 1), cB + hstep, voffB); PG8_STAGE(PG8_SA(0, 0), cA, voffA); PG8_STAGE(PG8_SA(0, 1), cA + hstep, voffA);
        if (wr == 1) PG8_BAR;
        PG8_WAIT_V(2); PG8_BAR;
        PG8_STAGE(PG8_SB(1, 0), cB + kstep, voffB); PG8_STAGE(PG8_SA(1, 0), cA + kstep, voffA); PG8_STAGE(PG8_SB(1, 1), cB + hstep + kstep, voffB);
        PG8_WAIT_V(6); PG8_BAR;
    } else {
        PG8_STAGE(PG8_SB(0, 0), cB, voffB); PG8_STAGE(PG8_SA(0, 0), cA, voffA); PG8_STAGE(PG8_SB(0, 1), cB + hstep, voffB); PG8_STAGE(PG8_SA(0, 1), cA + hstep, voffA);
        if (wr == 1) PG8_BAR;
        PG8_WAIT_V(4); PG8_BAR;
        PG8_STAGE(PG8_SB(1, 0), cB + kstep, voffB); PG8_STAGE(PG8_SA(1, 0), cA + kstep, voffA); PG8_STAGE(PG8_SB(1, 1), cB + hstep + kstep, voffB);
        PG8_WAIT_V(6); PG8_BAR;
    }
    for (;;) {
        const bool has_next = S.next(ui + 1, nxt);
        const char* nA = has_next ? (const char*)g.A + (size_t)nxt.pm * tstep : cA; const char* nB = has_next ? (const char*)g.Bt + (size_t)nxt.pn * tstep : cB;
        for (int t = 0; t < nt; t += 2) {
            const bool last = (t == nt - 2);
            const char* a1 = cA + (size_t)(t + 1) * kstep;
            const char* a2 = last ? nA : cA + (size_t)(t + 2) * kstep; const char* b2 = last ? nB : cB + (size_t)(t + 2) * kstep;
            const char* a3 = a2 + kstep; const char* b3 = b2 + kstep;
            if (last && has_next) S.a_ready(nxt);
            if constexpr (SP2) {
            PG8_LDB(B0, 0, 0); PG8_LDB(B1, 0, 1); PG8_SCHED; PG8_LDA(At, 0, 0); PG8_STAGE(PG8_SA(1, 1), a1 + hstep, voffA);
            PG8_WAIT_V(8); PG8_WAIT_L(0); PG8_BAR; PG8_MMA(0, 0, At, B0); PG8_MMA(0, 1, At, B1); PG8_BAR; PG8_SCHED;
            PG8_LDA(At, 0, 1); PG8_STAGE(PG8_SB(0, 0), b2, voffB); PG8_STAGE(PG8_SB(0, 1), b2 + hstep, voffB); PG8_STAGE(PG8_SA(0, 0), a2, voffA);
            PG8_WAIT_V(8); PG8_WAIT_L(0); PG8_BAR; PG8_MMA(1, 0, At, B0); PG8_MMA(1, 1, At, B1); PG8_BAR; PG8_SCHED;
            PG8_LDB(B0, 1, 0); PG8_LDB(B1, 1, 1); PG8_SCHED; PG8_LDA(At, 1, 0); PG8_STAGE(PG8_SA(0, 1), a2 + hstep, voffA);
            PG8_WAIT_V(8); PG8_WAIT_L(0); PG8_BAR; PG8_MMA(0, 0, At, B0); PG8_MMA(0, 1, At, B1); PG8_BAR; PG8_SCHED;
            PG8_LDA(At, 1, 1); PG8_STAGE(PG8_SB(1, 0), b3, voffB); PG8_STAGE(PG8_SB(1, 1), b3 + hstep, voffB); PG8_STAGE(PG8_SA(1, 0), a3, voffA);
            PG8_WAIT_V(8); PG8_WAIT_L(0); PG8_BAR; PG8_MMA(1, 0, At, B0); PG8_MMA(1, 1, At, B1); PG8_BAR; PG8_SCHED;
            } else {
            PG8_LDB(B0, 0, 0); PG8_SCHED; PG8_LDA(At, 0, 0); PG8_STAGE(PG8_SA(1, 1), a1 + hstep, voffA);
            PG8_WAIT_L(8); PG8_BAR; PG8_WAIT_L(0); PG8_MMA(0, 0, At, B0); PG8_BAR; PG8_SCHED;
            PG8_LDB(B1, 0, 1); PG8_STAGE(PG8_SB(0, 0), b2, voffB);
            PG8_BAR; PG8_WAIT_L(0); PG8_MMA(0, 1, At, B1); PG8_BAR;
            PG8_LDA(At, 0, 1); PG8_STAGE(PG8_SA(0, 0), a2, voffA);
            PG8_BAR; PG8_WAIT_L(0); PG8_MMA(1, 0, At, B0); PG8_BAR; PG8_SCHED;
            PG8_STAGE(PG8_SB(0, 1), b2 + hstep, voffB);
            PG8_WAIT_V(6); PG8_BAR; PG8_MMA(1, 1, At, B1); PG8_BAR;
            PG8_LDB(B0, 1, 0); PG8_SCHED; PG8_LDA(At, 1, 0); PG8_STAGE(PG8_SA(0, 1), a2 + hstep, voffA);
            PG8_WAIT_L(8); PG8_BAR; PG8_WAIT_L(0); PG8_MMA(0, 0, At, B0); PG8_BAR; PG8_SCHED;
            PG8_LDB(B1, 1, 1); PG8_STAGE(PG8_SB(1, 0), b3, voffB);
            PG8_BAR; PG8_WAIT_L(0); PG8_MMA(0, 1, At, B1); PG8_BAR;
            PG8_LDA(At, 1, 1); PG8_STAGE(PG8_SA(1, 0), a3, voffA);
            PG8_BAR; PG8_WAIT_L(0); PG8_MMA(1, 0, At, B0); PG8_BAR; PG8_SCHED;
            PG8_STAGE(PG8_SB(1, 1), b3 + hstep, voffB);
            PG8_WAIT_V(6); PG8_BAR; PG8_MMA(1, 1, At, B1); PG8_BAR;
            }
        }
        if constexpr (ALIGN_EPI) { if (wr == 0) PG8_BAR; }
        if constexpr (!Epi::AFTER_DRAIN) { E(acc, cur, wr, wc, fr, fq); S.done(cur); }
        if (!has_next) break;
#pragma unroll
        for (int a = 0; a < 2; ++a)
#pragma unroll
            for (int b = 0; b < 2; ++b)
#pragma unroll
                for (int m = 0; m < 4; ++m)
#pragma unroll
                    for (int n = 0; n < 2; ++n) acc[a][b][m][n] = (f32x4){0.f, 0.f, 0.f, 0.f};
        cur = nxt; cA = nA; cB = nB; ++ui;
        if constexpr (ALIGN_EPI) { if (wr == 1) PG8_BAR; }
    }
    PG8_WAIT_V(0);
    if constexpr (!ALIGN_EPI) { if (wr == 0) PG8_BAR; }
    PG8_BAR;
    if constexpr (Epi::AFTER_DRAIN) { E.fused(acc, cur, wr, wc, fr, fq, lds, wid, lane); S.done(cur); }
#undef PG8_SA
#undef PG8_SB
#undef PG8_STAGE
#undef PG8_LDA
#undef PG8_LDB
#undef PG8_MMA
#undef PG8_WAIT_V
#undef PG8_WAIT_L
#undef PG8_BAR
#undef PG8_SCHED
}
}

#define LAS __attribute__((address_space(3)))
typedef unsigned short bf16_t;
typedef short bf16x8 __attribute__((ext_vector_type(8)));
typedef short s16x4 __attribute__((ext_vector_type(4)));
typedef float f32x4 __attribute__((ext_vector_type(4)));
typedef float f32x16 __attribute__((ext_vector_type(16)));
typedef unsigned u32x4 __attribute__((ext_vector_type(4)));
typedef unsigned u32x2 __attribute__((ext_vector_type(2)));

constexpr int DM = 2048, NB = 4, SEQ = 4096, MT = NB * SEQ, NH = 16, DQK = 192, DV = 128, QL = 512, KVL = 512, LATP = 1280, LATN = 1088, DFF = 8192, NMOD = 6 * DM;
constexpr float EPS = 1e-6f;
constexpr size_t MiB = 1u << 20;
constexpr size_t WS_MOD = 1 * MiB, WS_CS = 2 * MiB;
constexpr size_t W_IN = 8 * MiB, W_UQ = 13 * MiB, W_UKV = 16 * MiB, W_O = 20 * MiB, W_CIN = 28 * MiB, W_COUT = 52 * MiB, W_UP = 60 * MiB, W_DN = 124 * MiB;
constexpr size_t WS_H = 192 * MiB, WS_Y = 256 * MiB, WS_LAT = 256 * MiB, WS_CQ = 336 * MiB, WS_CKV = 352 * MiB;
constexpr size_t WS_BIG = 384 * MiB, WS_Q = 384 * MiB, WS_K = 480 * MiB, WS_V = 576 * MiB, WS_XB = 640 * MiB, WS_END = 704 * MiB;
constexpr int LDS_BYTES = 139264;
constexpr int NTHREADS = 512;

__device__ __forceinline__ unsigned pk2(float lo, float hi) { typedef float f2 __attribute__((ext_vector_type(2))); typedef __bf16 b2 __attribute__((ext_vector_type(2))); f2 v = {lo, hi}; b2 b = __builtin_convertvector(v, b2); return __builtin_bit_cast(unsigned, b); }
__device__ __forceinline__ float bflo(unsigned w) { return __uint_as_float(w << 16); }
__device__ __forceinline__ float bfhi(unsigned w) { return __uint_as_float(w & 0xffff0000u); }
__device__ __forceinline__ float shx(float v, int mask, int lane) { return __int_as_float(__builtin_amdgcn_ds_bpermute((lane ^ mask) << 2, __float_as_int(v))); }
__device__ __forceinline__ float wave_sum(float v, int lane) {
#pragma unroll
    for (int o = 32; o >= 1; o >>= 1) v += shx(v, o, lane);
    return v;
}

#define CAS __attribute__((address_space(4)))
struct Params {
    const float* x; const float* c; const int* pos; const float* w_mod; const float* b_mod; const float* norm_g;
    const float* mla_w_in; const float* mla_g_q; const float* mla_g_kv; const float* mla_w_uq; const float* mla_w_ukv; const float* mla_w_o;
    const float* conv_w_in; const float* conv_w; const float* conv_w_out; const float* mlp_w_up; const float* mlp_w_down;
    float* out; unsigned char* ws; int ph_lo, ph_hi, use_cg, pad;
};

#define GASR __attribute__((address_space(1)))
__device__ __forceinline__ void transpose_item(const float* __restrict__ W, int K, int N, bf16_t* __restrict__ WT, int qperm  , LAS float* scr, int item, int lane) {
    const int nblk = N / 64, kb = item / nblk, nb = item % nblk, k0 = 64 * kb, n0 = 64 * nb;
    f32x4 v[16];
    const float* src = W + (size_t)(k0 + (lane >> 4)) * N + n0 + 4 * (lane & 15);
#pragma unroll
    for (int i = 0; i < 16; ++i) v[i] = __builtin_nontemporal_load((const f32x4*)(src + (size_t)(4 * i) * N));
#pragma unroll
    for (int i = 0; i < 16; ++i) { LAS float* d = scr + (4 * i + (lane >> 4)) * 65 + 4 * (lane & 15); d[0] = v[i][0]; d[1] = v[i][1]; d[2] = v[i][2]; d[3] = v[i][3]; }
    asm volatile("s_waitcnt lgkmcnt(0)" ::: "memory");
    const int c = lane & 7;
#pragma unroll
    for (int j = 0; j < 8; ++j) { const int n = (lane >> 3) + 8 * j; const LAS float* s = scr + (8 * c) * 65 + n;
        u32x4 o; o.x = pk2(s[0 * 65], s[1 * 65]); o.y = pk2(s[2 * 65], s[3 * 65]); o.z = pk2(s[4 * 65], s[5 * 65]); o.w = pk2(s[6 * 65], s[7 * 65]);
        int nr = n0 + n;
        if (qperm == 1) { const int hh = nr / 192, d = nr % 192; if (d >= 128) { const int j2 = d - 128; nr = hh * 192 + 128 + ((j2 < 32) ? 2 * j2 : 2 * (j2 - 32) + 1); } }
        else if (qperm == 2) { if (nr < DM) nr += 2 * DM; else { const int u_ = nr >= 2 * DM, ch = nr - (u_ ? 2 * DM : DM); nr = (ch >> 7) * 256 + u_ * 128 + (ch & 127); } }
        *(GASR u32x4*)(WT + (size_t)nr * K + k0 + 8 * c) = o; }
    asm volatile("s_waitcnt lgkmcnt(0)" ::: "memory");
}

__device__ __forceinline__ float inv_freq_f(int j) {
    const int a = j >> 3, b = j & 7;
    const float fb = b == 0 ? 1.0f : b == 1 ? 0.7498942093324559f : b == 2 ? 0.5623413251903491f : b == 3 ? 0.4216965034285822f : b == 4 ? 0.31622776601683794f : b == 5 ? 0.23713737056616552f : b == 6 ? 0.1778279410038923f : 0.1333521432163324f;
    const float fa = a == 0 ? 1.0f : a == 1 ? 0.1f : a == 2 ? 0.01f : 0.001f;
    return fa * fb;
}
__device__ __forceinline__ void sincos_acc(float angf, float& c, float& s) {
    const double ang = (double)angf;
    const double n = __builtin_rint(ang * 0.6366197723675814);
    double rd = __builtin_fma(-n, 1.5707963267948966, ang); rd = __builtin_fma(-n, 6.123233995736766e-17, rd);
    const float r = (float)rd, z = r * r;
    const float sr = r + r * z * (-1.6666654611e-1f + z * (8.3321608736e-3f + z * -1.9515295891e-4f));
    const float cr = 1.0f - 0.5f * z + z * z * (4.166664568298827e-2f + z * (-1.388731625493765e-3f + z * 2.443315711809948e-5f));
    const int q = ((int)n) & 3;
    s = (q == 0) ? sr : (q == 1) ? cr : (q == 2) ? -sr : -cr;
    c = (q == 0) ? cr : (q == 1) ? -sr : (q == 2) ? -cr : sr;
}

__device__ __forceinline__ void p0_prologue(const CAS Params& P, unsigned char* ws, LAS unsigned char* lds, int tid, int lane, int wave, int G, int bid) {
    float* mod = (float*)(ws + WS_MOD); float* cs = (float*)(ws + WS_CS);
    for (int i = bid * NTHREADS + tid; i < MT * 32; i += G * NTHREADS) { const int t = i >> 5, j = i & 31;
        const float ang = (float)P.pos[t] * inv_freq_f(j); float c_, s_; sincos_acc(ang, c_, s_); cs[2 * i] = c_; cs[2 * i + 1] = s_; }
    LAS float* condL = (LAS float*)lds; LAS float* red = (LAS float*)(lds + 32768);
    for (int i = tid; i < NB * DM; i += NTHREADS) { const float v = P.c[i]; condL[i] = v / (1.f + __expf(-v)); }
    __syncthreads();
    for (int unit = bid; unit < 2 * (NMOD / 32); unit += G) {
        const int layer = unit / (NMOD / 32), cb = unit % (NMOD / 32);
        const float* W = P.w_mod + (size_t)layer * DM * NMOD + cb * 32 + 4 * (lane & 7);
        const int kph = wave * 8 + (lane >> 3);
        f32x4 acc[4];
#pragma unroll
        for (int b = 0; b < 4; ++b) acc[b] = (f32x4){0.f, 0.f, 0.f, 0.f};
#pragma unroll 16
        for (int kk = 0; kk < 32; ++kk) { const int k = kph + 64 * kk; const f32x4 w = __builtin_nontemporal_load((const f32x4*)(W + (size_t)k * NMOD));
#pragma unroll
            for (int b = 0; b < 4; ++b) acc[b] += w * condL[b * DM + k]; }
#pragma unroll
        for (int b = 0; b < 4; ++b) *(LAS f32x4*)(red + ((kph * 4 + b) * 32 + 4 * (lane & 7))) = acc[b];
        __syncthreads();
        if (tid < 128) { const int b = tid >> 5, cc = tid & 31; float s = 0.f;
#pragma unroll 8
            for (int kp = 0; kp < 64; ++kp) s += red[(kp * 4 + b) * 32 + cc];
            mod[(size_t)(layer * 4 + b) * NMOD + cb * 32 + cc] = s + P.b_mod[layer * NMOD + cb * 32 + cc]; }
        __syncthreads();
    }
    LAS float* scr = (LAS float*)(lds + wave * 16640);
    const int gw = bid * 8 + wave, NGW = G * 8;
    constexpr int I_IN = (DM / 64) * (LATN / 64), I_UQ = (QL / 64) * (NH * DQK / 64), I_UKV = (KVL / 64) * (NH * 256 / 64), I_O = (DM / 64) * (DM / 64),
                  I_CIN = (DM / 64) * (3 * DM / 64), I_UP = (DM / 64) * (DFF / 64), I_DN = (DFF / 64) * (DM / 64);
    constexpr int NITEMS = I_IN + I_UQ + I_UKV + I_O + I_CIN + I_O + 2 * I_UP + I_DN;
    for (int it = gw; it < NITEMS; it += NGW) {
        int r = it;
        if (r < I_IN) { transpose_item(P.mla_w_in, DM, LATN, (bf16_t*)(ws + W_IN), 0, scr, r, lane); continue; } r -= I_IN;
        if (r < I_UQ) { transpose_item(P.mla_w_uq, QL, NH * DQK, (bf16_t*)(ws + W_UQ), 1, scr, r, lane); continue; } r -= I_UQ;
        if (r < I_UKV) { transpose_item(P.mla_w_ukv, KVL, NH * 256, (bf16_t*)(ws + W_UKV), 0, scr, r, lane); continue; } r -= I_UKV;
        if (r < I_O) { transpose_item(P.mla_w_o, DM, DM, (bf16_t*)(ws + W_O), 0, scr, r, lane); continue; } r -= I_O;
        if (r < I_CIN) { transpose_item(P.conv_w_in, DM, 3 * DM, (bf16_t*)(ws + W_CIN), 2, scr, r, lane); continue; } r -= I_CIN;
        if (r < I_O) { transpose_item(P.conv_w_out, DM, DM, (bf16_t*)(ws + W_COUT), 0, scr, r, lane); continue; } r -= I_O;
        if (r < 2 * I_UP) { const int l = r / I_UP; transpose_item(P.mlp_w_up + (size_t)l * DM * DFF, DM, DFF, (bf16_t*)(ws + W_UP) + (size_t)l * DM * DFF, 0, scr, r % I_UP, lane); continue; } r -= 2 * I_UP;
        { transpose_item(P.mlp_w_down, DFF, DM, (bf16_t*)(ws + W_DN), 0, scr, r, lane); }
    }
}

__device__ __forceinline__ void deferred_convert(const CAS Params& P, unsigned char* ws, LAS unsigned char* lds, int lane, int wave, int G, int bid) {
    constexpr int I_DN = (DFF / 64) * (DM / 64);
    const int nwg = (MT / 256) * (LATP / 256), rounds = (nwg + G - 1) / G, nlight = rounds * G - nwg, first_light = G - nlight;
    int gwl, ngwl;
    if (nlight > 0) { if (bid < first_light) return; gwl = (bid - first_light) * 8 + wave; ngwl = nlight * 8; } else { gwl = bid * 8 + wave; ngwl = G * 8; }
    LAS float* scr = (LAS float*)(lds + wave * 16640);
    for (int it = gwl; it < I_DN; it += ngwl) transpose_item(P.mlp_w_down + (size_t)DM * DFF, DFF, DM, (bf16_t*)(ws + W_DN) + (size_t)DM * DFF, 0, scr, it, lane);
}

__device__ __forceinline__ void row_prenorm(const float* __restrict__ x, const float* __restrict__ g, const float* __restrict__ modl  , int shi, int sci, bf16_t* __restrict__ h, int lane, int gw, int NGW) {
    for (int m0 = gw * 8; m0 < MT; m0 += NGW * 8) {
        const int b = m0 / SEQ; const float* md = modl + (size_t)b * NMOD;
        f32x4 A[8], B[8];
#pragma unroll
        for (int j = 0; j < 8; ++j) { const int c = 4 * lane + 256 * j; const f32x4 gg = *(const GASR f32x4*)(g + c), sc = *(const GASR f32x4*)(md + sci * DM + c); A[j] = gg * (sc + 1.f); B[j] = *(const GASR f32x4*)(md + shi * DM + c); }
#pragma unroll 1
        for (int r = 0; r < 8; ++r) { const size_t row = (size_t)(m0 + r);
            f32x4 v[8]; float ss = 0.f;
#pragma unroll
            for (int j = 0; j < 8; ++j) { v[j] = *(const GASR f32x4*)(x + row * DM + 4 * lane + 256 * j); ss += (v[j][0] * v[j][0] + v[j][1] * v[j][1]) + (v[j][2] * v[j][2] + v[j][3] * v[j][3]); }
            const float rstd = 1.0f / sqrtf(wave_sum(ss, lane) * (1.0f / DM) + EPS);
#pragma unroll
            for (int j = 0; j < 8; ++j) { const f32x4 o = v[j] * rstd * A[j] + B[j]; u32x2 w; w.x = pk2(o[0], o[1]); w.y = pk2(o[2], o[3]); *(GASR u32x2*)(h + row * DM + 4 * lane + 256 * j) = w; }
        }
    }
}
__device__ __forceinline__ void row_resid(const float* __restrict__ xin_f, const bf16_t* xin_b, const bf16_t* __restrict__ y, float* __restrict__ xout_f, bf16_t* xout_b, bf16_t* __restrict__ h,
                                          const float* __restrict__ gpost, const float* __restrict__ gate  , const float* __restrict__ gpre, const float* __restrict__ sc, const float* __restrict__ sh,
                                          int lane, int gw, int NGW) {
    for (int m0 = gw * 8; m0 < MT; m0 += NGW * 8) {
        const int b = m0 / SEQ;
        f32x4 Gv[8];
#pragma unroll
        for (int j = 0; j < 8; ++j) { const int c = 4 * lane + 256 * j; Gv[j] = *(const GASR f32x4*)(gpost + c) * *(const GASR f32x4*)(gate + (size_t)b * NMOD + c); }
#pragma unroll 1
        for (int r = 0; r < 8; ++r) { const size_t row = (size_t)(m0 + r);
            f32x4 v[8], xv[8]; float ss = 0.f;
#pragma unroll
            for (int j = 0; j < 8; ++j) { const u32x2 yw = *(const GASR u32x2*)(y + row * DM + 4 * lane + 256 * j); v[j] = (f32x4){bflo(yw.x), bfhi(yw.x), bflo(yw.y), bfhi(yw.y)};
                ss += (v[j][0] * v[j][0] + v[j][1] * v[j][1]) + (v[j][2] * v[j][2] + v[j][3] * v[j][3]); }
            if (xin_f) {
#pragma unroll
                for (int j = 0; j < 8; ++j) xv[j] = *(const GASR f32x4*)(xin_f + row * DM + 4 * lane + 256 * j);
            } else {
#pragma unroll
                for (int j = 0; j < 8; ++j) { const u32x2 xw = *(const GASR u32x2*)(xin_b + row * DM + 4 * lane + 256 * j); xv[j] = (f32x4){bflo(xw.x), bfhi(xw.x), bflo(xw.y), bfhi(xw.y)}; }
            }
            const float rstd = 1.0f / sqrtf(wave_sum(ss, lane) * (1.0f / DM) + EPS);
            float s2 = 0.f;
#pragma unroll
            for (int j = 0; j < 8; ++j) { xv[j] = xv[j] + v[j] * rstd * Gv[j]; s2 += (xv[j][0] * xv[j][0] + xv[j][1] * xv[j][1]) + (xv[j][2] * xv[j][2] + xv[j][3] * xv[j][3]); }
            if (xout_f) {
#pragma unroll
                for (int j = 0; j < 8; ++j) *(GASR f32x4*)(xout_f + row * DM + 4 * lane + 256 * j) = xv[j];
            } else {
#pragma unroll
                for (int j = 0; j < 8; ++j) { u32x2 w; w.x = pk2(xv[j][0], xv[j][1]); w.y = pk2(xv[j][2], xv[j][3]); *(GASR u32x2*)(xout_b + row * DM + 4 * lane + 256 * j) = w; }
            }
            if (h) { const float rs2 = 1.0f / sqrtf(wave_sum(s2, lane) * (1.0f / DM) + EPS);
#pragma unroll
                for (int j = 0; j < 8; ++j) { const int c = 4 * lane + 256 * j;
                    const f32x4 A = *(const GASR f32x4*)(gpre + c) * (*(const GASR f32x4*)(sc + (size_t)b * NMOD + c) + 1.f), B = *(const GASR f32x4*)(sh + (size_t)b * NMOD + c);
                    const f32x4 o = xv[j] * rs2 * A + B; u32x2 w; w.x = pk2(o[0], o[1]); w.y = pk2(o[2], o[3]); *(GASR u32x2*)(h + row * DM + c) = w; } }
        }
    }
}
__device__ __forceinline__ void row_latent(const bf16_t* __restrict__ lat, const float* __restrict__ gq, const float* __restrict__ gkv, const float* __restrict__ cs,
                                           bf16_t* __restrict__ cq, bf16_t* __restrict__ ckv, bf16_t* __restrict__ Kb, int lane, int gw, int NGW) {
    for (int row = gw; row < MT; row += NGW) { const bf16_t* lr = lat + (size_t)row * LATP;
#pragma unroll
        for (int part = 0; part < 2; ++part) { const bf16_t* src = lr + part * 512; const float* gg = part ? gkv : gq; bf16_t* dst = (part ? ckv : cq) + (size_t)row * 512;
            const u32x2 r0 = *(const GASR u32x2*)(src + 4 * lane), r1 = *(const GASR u32x2*)(src + 256 + 4 * lane);
            const f32x4 a0 = {bflo(r0.x), bfhi(r0.x), bflo(r0.y), bfhi(r0.y)}, a1 = {bflo(r1.x), bfhi(r1.x), bflo(r1.y), bfhi(r1.y)};
            const float ss = (a0[0] * a0[0] + a0[1] * a0[1]) + (a0[2] * a0[2] + a0[3] * a0[3]) + (a1[0] * a1[0] + a1[1] * a1[1]) + (a1[2] * a1[2] + a1[3] * a1[3]);
            const float rstd = 1.0f / sqrtf(wave_sum(ss, lane) * (1.0f / 512.f) + EPS);
            const f32x4 o0 = a0 * rstd * *(const GASR f32x4*)(gg + 4 * lane), o1 = a1 * rstd * *(const GASR f32x4*)(gg + 256 + 4 * lane);
            u32x2 w0, w1; w0.x = pk2(o0[0], o0[1]); w0.y = pk2(o0[2], o0[3]); w1.x = pk2(o1[0], o1[1]); w1.y = pk2(o1[2], o1[3]);
            *(GASR u32x2*)(dst + 4 * lane) = w0; *(GASR u32x2*)(dst + 256 + 4 * lane) = w1; }
        if (lane < 32) { const float x1 = __uint_as_float((unsigned)lr[1024 + lane] << 16), x2 = __uint_as_float((unsigned)lr[1056 + lane] << 16), c_ = cs[(size_t)row * 64 + 2 * lane], s_ = cs[(size_t)row * 64 + 2 * lane + 1];
            const unsigned w = pk2(x1 * c_ - x2 * s_, x2 * c_ + x1 * s_);
#pragma unroll
            for (int hh = 0; hh < NH; ++hh) *(GASR unsigned*)(Kb + ((size_t)row * NH + hh) * DQK + 128 + 2 * lane) = w; }
    }
}
__device__ __forceinline__ void row_conv(const bf16_t* __restrict__ bb, const bf16_t* __restrict__ zz, const float* __restrict__ cw, bf16_t* __restrict__ gz, int lane, int gw, int NGW) {
    for (int m0 = gw * 8; m0 < MT; m0 += NGW * 8) {
        const int s0 = m0 % SEQ;
#pragma unroll 1
        for (int j = 0; j < 4; ++j) { const int c0 = 8 * lane + 512 * j;
            float w0[8], w1[8], w2[8], zm2[8], zm1[8];
            { const f32x4 a = *(const GASR f32x4*)(cw + c0), b = *(const GASR f32x4*)(cw + c0 + 4), c = *(const GASR f32x4*)(cw + DM + c0), d = *(const GASR f32x4*)(cw + DM + c0 + 4), e = *(const GASR f32x4*)(cw + 2 * DM + c0), f = *(const GASR f32x4*)(cw + 2 * DM + c0 + 4);
#pragma unroll
              for (int i = 0; i < 4; ++i) { w0[i] = a[i]; w0[4 + i] = b[i]; w1[i] = c[i]; w1[4 + i] = d[i]; w2[i] = e[i]; w2[4 + i] = f[i]; } }
#pragma unroll
            for (int i = 0; i < 8; ++i) { zm2[i] = 0.f; zm1[i] = 0.f; }
            if (s0 >= 2) { const u32x4 za = *(const GASR u32x4*)(zz + (size_t)(m0 - 2) * DM + c0), zb = *(const GASR u32x4*)(zz + (size_t)(m0 - 1) * DM + c0);
#pragma unroll
                for (int i = 0; i < 4; ++i) { zm2[2 * i] = bflo(za[i]); zm2[2 * i + 1] = bfhi(za[i]); zm1[2 * i] = bflo(zb[i]); zm1[2 * i + 1] = bfhi(zb[i]); } }
#pragma unroll
            for (int r = 0; r < 8; ++r) { const size_t off = (size_t)(m0 + r) * DM + c0; const u32x4 bv = *(const GASR u32x4*)(bb + off), zv = *(const GASR u32x4*)(zz + off);
                float z[8], o[8];
#pragma unroll
                for (int i = 0; i < 4; ++i) { z[2 * i] = bflo(zv[i]); z[2 * i + 1] = bfhi(zv[i]); }
#pragma unroll
                for (int i = 0; i < 4; ++i) { o[2 * i] = bflo(bv[i]) * (w0[2 * i] * zm2[2 * i] + w1[2 * i] * zm1[2 * i] + w2[2 * i] * z[2 * i]); o[2 * i + 1] = bfhi(bv[i]) * (w0[2 * i + 1] * zm2[2 * i + 1] + w1[2 * i + 1] * zm1[2 * i + 1] + w2[2 * i + 1] * z[2 * i + 1]); }
                u32x4 w; w.x = pk2(o[0], o[1]); w.y = pk2(o[2], o[3]); w.z = pk2(o[4], o[5]); w.w = pk2(o[6], o[7]);
                *(GASR u32x4*)(gz + off) = w;
#pragma unroll
                for (int i = 0; i < 8; ++i) { zm2[i] = zm1[i]; zm1[i] = z[i]; } }
        }
    }
}

namespace att {
constexpr int KSTR = 400, VSTR = 320, KT_BYTES = 64 * KSTR, VT_BYTES = 64 * VSTR, STG = KT_BYTES + VT_BYTES, NSTG = 3;
static_assert(NSTG * STG <= 138240, "attention LDS");
#define GAS __attribute__((address_space(1)))
#define ABAR() do { asm volatile("s_waitcnt lgkmcnt(0)" ::: "memory"); __builtin_amdgcn_s_barrier(); asm volatile("" ::: "memory"); } while (0)
#define MFMA32(a, b, c) __builtin_amdgcn_mfma_f32_32x32x16_bf16((a), (b), (c), 0, 0, 0)
__device__ __forceinline__ float max3f(float a, float b, float c) { float r; asm("v_max3_f32 %0, %1, %2, %3" : "=v"(r) : "v"(a), "v"(b), "v"(c)); return r; }
__device__ __forceinline__ s16x4 vtr(const LAS unsigned char* p) { typedef short v4i16_t __attribute__((ext_vector_type(4))); return __builtin_bit_cast(s16x4, __builtin_amdgcn_ds_read_tr16_b64_v4i16((LAS v4i16_t*)p)); }
__device__ __forceinline__ bf16x8 pack8(const f32x16& p, int o) { u32x4 w; w.x = pk2(p[o], p[o + 1]); w.y = pk2(p[o + 2], p[o + 3]); w.z = pk2(p[o + 4], p[o + 5]); w.w = pk2(p[o + 6], p[o + 7]); return __builtin_bit_cast(bf16x8, w); }

__device__ __forceinline__ void attn_unit(int b, int h, int qb, const bf16_t* __restrict__ Q, const bf16_t* __restrict__ Kb, const bf16_t* __restrict__ Vb, bf16_t* __restrict__ O, LAS unsigned char* lds, const int tid) {
    const int lane = tid & 63, wid = __builtin_amdgcn_readfirstlane(tid >> 6), r32 = lane & 31, hi = lane >> 5, late = wid >> 2;
    const size_t tok0 = (size_t)b * SEQ;
    const int qw0 = qb * 256 + wid * 32;
    const bf16_t* qp = Q + (tok0 + qw0) * (NH * DQK) + h * DQK + (unsigned)(r32 * (NH * DQK) + hi * 8);
    bf16x8 qf[12];
#pragma unroll
    for (int d0 = 0; d0 < 12; ++d0) qf[d0] = *(const GAS bf16x8*)(qp + d0 * 16);
    const bf16_t* kgb = Kb + (tok0 * NH + h) * DQK; const bf16_t* vgb = Vb + tok0 * (NH * DV) + h * DV;
    const unsigned kgo = (unsigned)((tid >> 3) * (NH * DQK) + (tid & 7) * 8), vgo = (unsigned)((tid >> 3) * (NH * DV) + (tid & 7) * 8);
    LAS unsigned char* klp = lds + (tid >> 3) * KSTR + (tid & 7) * 16;
    LAS unsigned char* vlp = lds + KT_BYTES + (tid >> 3) * VSTR + (tid & 7) * 16;
    const int kfo = r32 * KSTR + hi * 16;
    const int vfo = KT_BYTES + (4 * hi + ((lane & 15) >> 2)) * VSTR + (16 * ((lane >> 4) & 1) + 4 * (lane & 3)) * 2;
    f32x16 o[4];
#pragma unroll
    for (int i = 0; i < 4; ++i)
#pragma unroll
        for (int r = 0; r < 16; ++r) o[i][r] = 0.f;
    float m = -1e30f, l = 0.f;
    const int NT = 4 * (qb + 1);
    u32x4 kr[3], vr[2];
#pragma unroll
    for (int i = 0; i < 3; ++i) kr[i] = *(const GAS u32x4*)(kgb + (kgo + i * 64));
#pragma unroll
    for (int i = 0; i < 2; ++i) vr[i] = *(const GAS u32x4*)(vgb + (vgo + i * 64));
#pragma unroll
    for (int i = 0; i < 3; ++i) *(LAS u32x4*)(klp + i * 128) = kr[i];
#pragma unroll
    for (int i = 0; i < 2; ++i) *(LAS u32x4*)(vlp + i * 128) = vr[i];
    if (NT > 1) {
#pragma unroll
        for (int i = 0; i < 3; ++i) kr[i] = *(const GAS u32x4*)(kgb + (size_t)64 * (NH * DQK) + (kgo + i * 64));
#pragma unroll
        for (int i = 0; i < 2; ++i) vr[i] = *(const GAS u32x4*)(vgb + (size_t)64 * (NH * DV) + (vgo + i * 64)); }
    ABAR();
    if (late) ABAR();
    bf16x8 pf[4];
#pragma unroll
    for (int i = 0; i < 4; ++i) pf[i] = (bf16x8){0, 0, 0, 0, 0, 0, 0, 0};
    int sprev = 2 * STG, scur = 0, snext = STG;
#pragma unroll 1
    for (int t = 0; ; ++t) {
        const bool more = (t + 1 < NT);
        f32x16 s0, s1;
        if (t >= 1 && 64 * (t - 1) <= qw0 + 31) {
            const LAS unsigned char* vp = lds + sprev + vfo;
            s16x4 vA[8], vB[8];
#define LDV(dst, ks) do { _Pragma("unroll") for (int db = 0; db < 4; ++db) { dst[2 * db] = vtr(vp + (16 * (ks)) * VSTR + 64 * db); dst[2 * db + 1] = vtr(vp + (16 * (ks) + 8) * VSTR + 64 * db); } } while (0)
#define PVM(srcv, ks) do { _Pragma("unroll") for (int db = 0; db < 4; ++db) o[db] = MFMA32(__builtin_shufflevector(srcv[2 * db], srcv[2 * db + 1], 0, 1, 2, 3, 4, 5, 6, 7), pf[ks], o[db]); } while (0)
            LDV(vA, 0); __builtin_amdgcn_sched_barrier(0);
            LDV(vB, 1); __builtin_amdgcn_sched_barrier(0); PVM(vA, 0); __builtin_amdgcn_sched_barrier(0);
            LDV(vA, 2); __builtin_amdgcn_sched_barrier(0); PVM(vB, 1); __builtin_amdgcn_sched_barrier(0);
            LDV(vB, 3); __builtin_amdgcn_sched_barrier(0); PVM(vA, 2); __builtin_amdgcn_sched_barrier(0);
            PVM(vB, 3); __builtin_amdgcn_sched_barrier(0);
#undef LDV
#undef PVM
        }
        if (t < NT && 64 * t <= qw0 + 31) {
            const LAS unsigned char* kp = lds + scur + kfo;
#pragma unroll
            for (int r = 0; r < 16; ++r) { s0[r] = 0.f; s1[r] = 0.f; }
            bf16x8 kA[2], kB[2], kC[2];
#define LDK(dst, d) do { dst[0] = *(const LAS bf16x8*)(kp + (d) * 32); dst[1] = *(const LAS bf16x8*)(kp + 32 * KSTR + (d) * 32); } while (0)
#define SKM(srck, d) do { s0 = MFMA32(srck[0], qf[d], s0); s1 = MFMA32(srck[1], qf[d], s1); } while (0)
#define SB() __builtin_amdgcn_sched_barrier(0)
            LDK(kA, 0); LDK(kB, 1); SB();
            LDK(kC, 2); SB(); SKM(kA, 0); SB();
            LDK(kA, 3); SB(); SKM(kB, 1); SB();
            LDK(kB, 4); SB(); SKM(kC, 2); SB();
            LDK(kC, 5); SB(); SKM(kA, 3); SB();
            LDK(kA, 6); SB(); SKM(kB, 4); SB();
            LDK(kB, 7); SB(); SKM(kC, 5); SB();
            LDK(kC, 8); SB(); SKM(kA, 6); SB();
            LDK(kA, 9); SB(); SKM(kB, 7); SB();
            LDK(kB, 10); SB(); SKM(kC, 8); SB();
            LDK(kC, 11); SB(); SKM(kA, 9); SB();
            SKM(kB, 10); SB(); SKM(kC, 11); SB();
#undef LDK
#undef SKM
#undef SB
        }
        if (more) { LAS unsigned char* kl = klp + snext; LAS unsigned char* vl = vlp + snext;
#pragma unroll
            for (int i = 0; i < 3; ++i) *(LAS u32x4*)(kl + i * 128) = kr[i];
#pragma unroll
            for (int i = 0; i < 2; ++i) *(LAS u32x4*)(vl + i * 128) = vr[i]; }
        if (t == NT) break;
        ABAR();
        if (t + 2 < NT) { const bf16_t* kg = kgb + (size_t)(t + 2) * 64 * (NH * DQK); const bf16_t* vg = vgb + (size_t)(t + 2) * 64 * (NH * DV);
#pragma unroll
            for (int i = 0; i < 3; ++i) kr[i] = *(const GAS u32x4*)(kg + (kgo + i * 64));
#pragma unroll
            for (int i = 0; i < 2; ++i) vr[i] = *(const GAS u32x4*)(vg + (vgo + i * 64)); }
        if (64 * t <= qw0 + 31) {
            if (64 * t + 63 > qw0) { const int qpos = qw0 + r32, kb = 64 * t + 4 * hi;
#pragma unroll
                for (int r = 0; r < 16; ++r) { const int key = kb + (r & 3) + 8 * (r >> 2); if (key > qpos) s0[r] = -1e30f; if (key + 32 > qpos) s1[r] = -1e30f; } }
            float mxa = max3f(s0[0], s0[1], s1[0]), mxb = max3f(s0[2], s0[3], s1[1]); mxa = max3f(mxa, s1[2], s1[3]);
#pragma unroll
            for (int r = 4; r < 16; r += 4) { mxa = max3f(mxa, s0[r], s0[r + 1]); mxb = max3f(mxb, s0[r + 2], s0[r + 3]); mxa = max3f(mxa, s1[r], s1[r + 1]); mxb = max3f(mxb, s1[r + 2], s1[r + 3]); }
            float mx = max3f(mxa, mxb, mxb);
            mx = fmaxf(mx, shx(mx, 32, lane));
            const bool bump = mx > m + 8.f;
            if (__any(bump)) { const float mnew = bump ? mx : m, alpha = __builtin_amdgcn_exp2f(m - mnew); m = mnew; l *= alpha;
#pragma unroll
                for (int i = 0; i < 4; ++i)
#pragma unroll
                    for (int r = 0; r < 16; ++r) o[i][r] *= alpha; }
            float ls = 0.f;
#pragma unroll
            for (int r = 0; r < 16; ++r) { s0[r] = __builtin_amdgcn_exp2f(s0[r] - m); s1[r] = __builtin_amdgcn_exp2f(s1[r] - m); ls += s0[r] + s1[r]; }
            l += ls;
            pf[0] = pack8(s0, 0); pf[1] = pack8(s0, 8); pf[2] = pack8(s1, 0); pf[3] = pack8(s1, 8);
        }
        ABAR();
        { const int tmp = sprev; sprev = scur; scur = snext; snext = tmp; }
    }
    if (!late) ABAR();
    ABAR();
    const float lt = l + shx(l, 32, lane), inv = 1.0f / lt;
    int lane2 = lane; asm volatile("" : "+v"(lane2));
    bf16_t* op = O + (tok0 + qw0) * (NH * DV) + h * DV + (unsigned)((lane2 & 31) * (NH * DV) + 4 * (lane2 >> 5));
#pragma unroll
    for (int db = 0; db < 4; ++db)
#pragma unroll
        for (int rg = 0; rg < 4; ++rg) { u32x2 w; w.x = pk2(o[db][4 * rg] * inv, o[db][4 * rg + 1] * inv); w.y = pk2(o[db][4 * rg + 2] * inv, o[db][4 * rg + 3] * inv);
            *(GAS u32x2*)(op + 32 * db + 8 * rg) = w; }
}
}

typedef __attribute__((address_space(1))) unsigned gu32;
#define XB_TMO      128
#define XB_XCNT(j)  (256  + 64 * (j))
#define XB_XSUB(j)  (1280 + 64 * (j))
#define XB_XGEN(j)  (2304 + 64 * (j))
#define XB_TOP      3328
#define XB_TOPGEN   3392
#define XCD_BAR_WORDS 3456
#define XB_SPIN_CAP (1u << 18)

__device__ __forceinline__ unsigned xb_ld(unsigned* p)              { return __hip_atomic_load(p, __ATOMIC_RELAXED, __HIP_MEMORY_SCOPE_AGENT); }
__device__ __forceinline__ unsigned xb_add(unsigned* p, unsigned v) { return __hip_atomic_fetch_add(p, v, __ATOMIC_RELAXED, __HIP_MEMORY_SCOPE_AGENT); }
__device__ __forceinline__ unsigned xb_xcc_id() { return (unsigned)__builtin_amdgcn_s_getreg((3 << 11) | 20) & 0xFu; }
#define XB_SPIN(cond, bar) do { unsigned _sp = 0; while (cond) { __builtin_amdgcn_s_sleep(1); \
    if ((++_sp & 255u) == 0u) { if (xb_ld(&(bar)[XB_TMO])) break; if (_sp > XB_SPIN_CAP) { atomicAdd(&(bar)[XB_TMO], 1u); break; } } } } while (0)

struct XcdBarrier {
    unsigned* bar; unsigned x;
    volatile LAS unsigned* st;
};

__device__ __forceinline__ XcdBarrier xcd_barrier_post(unsigned* bar, volatile LAS unsigned* st) {
    XcdBarrier b; b.bar = bar; b.x = xb_xcc_id(); b.st = st;
    if (threadIdx.x == 0) (void)xb_add(&bar[XB_XCNT(b.x)], 1u);
    return b;
}
__device__ __forceinline__ void xcd_barrier_complete(unsigned* bar, unsigned x, unsigned& nloc, unsigned& nx) {
    const unsigned G = gridDim.x * gridDim.y * gridDim.z;
    unsigned sum, cnt, mine, sp = 0u;
    for (;;) {
        sum = 0u; cnt = 0u; mine = 0u;
#pragma unroll
        for (unsigned j = 0; j < 16; ++j) { const unsigned c = xb_ld(&bar[XB_XCNT(j)]); sum += c; cnt += (c > 0u) ? 1u : 0u; mine = (j == x) ? c : mine; }
        if (sum == G) break;
        __builtin_amdgcn_s_sleep(1);
        if ((++sp & 255u) == 0u) { if (xb_ld(&bar[XB_TMO])) break; if (sp > XB_SPIN_CAP) { atomicAdd(&bar[XB_TMO], 1u); break; } }
    }
    nloc = mine > 0u ? mine : 1u; nx = cnt > 0u ? cnt : 1u;
}

__device__ __forceinline__ void xcd_barrier(const XcdBarrier& b) {
    asm volatile("s_waitcnt vmcnt(0)" ::: "memory");
    __syncthreads();
    if (threadIdx.x == 0) {
        unsigned* bar = b.bar;
        __builtin_amdgcn_s_waitcnt(0);
        unsigned nloc = b.st[0], nx = b.st[1];
        if (nloc == 0u) { xcd_barrier_complete(bar, b.x, nloc, nx); b.st[0] = nloc; b.st[1] = nx; }
        const unsigned old = xb_add(&bar[XB_XSUB(b.x)], 1u);
        const unsigned gen = old / nloc;
        if (old + 1u == (gen + 1u) * nloc) {
            __builtin_amdgcn_fence(__ATOMIC_RELEASE, "agent");
            asm volatile("s_waitcnt vmcnt(0)" ::: "memory");
            const unsigned og = xb_add(&bar[XB_TOP], 1u);
            const unsigned tg = og / nx;
            if (og + 1u == (tg + 1u) * nx) xb_add(&bar[XB_TOPGEN], 1u);
            else XB_SPIN(xb_ld(&bar[XB_TOPGEN]) == tg, bar);
            __builtin_amdgcn_fence(__ATOMIC_ACQUIRE, "agent");
            xb_add(&bar[XB_XGEN(b.x)], 1u);
            asm volatile("s_waitcnt vmcnt(0)" ::: "memory");
        } else {
            XB_SPIN(xb_ld(&bar[XB_XGEN(b.x)]) == gen, bar);
            __builtin_amdgcn_fence(__ATOMIC_ACQUIRE, "agent");
            asm volatile("s_waitcnt vmcnt(0)" ::: "memory");
        }
    }
    __syncthreads();
}

__global__ void __launch_bounds__(NTHREADS) fwd_megakernel(Params P0_) {
    extern __shared__ __attribute__((aligned(16))) unsigned char lds_raw[];
    LAS unsigned char* lds = (LAS unsigned char*)lds_raw;
    cg::grid_group grid = cg::this_grid();
    const float QSCALE = 0.07216878364870322f * 1.4426950408889634f;
    volatile LAS unsigned* bst = (volatile LAS unsigned*)(lds + 138240);
    if (threadIdx.x < 4) bst[threadIdx.x] = 0u;
    __syncthreads();
    const XcdBarrier xbar = xcd_barrier_post((unsigned*)P0_.ws, bst);

#ifndef DUP_MASK
#define DUP_MASK 0u
#endif
    const int it_lo = 2 * P0_.ph_lo, it_hi = 2 * P0_.ph_hi;
#pragma unroll 1
    for (int it = it_lo; it < it_hi; ++it) {
        const int ph = it >> 1;
        if ((it & 1) && !((DUP_MASK >> ph) & 1u)) continue;
        int tid = threadIdx.x; asm volatile("" : "+v"(tid));
        int bid = blockIdx.x; asm volatile("" : "+s"(bid));
        int G = gridDim.x; asm volatile("" : "+s"(G));
        const CAS Params* pp_ = (const CAS Params*)__builtin_amdgcn_kernarg_segment_ptr(); asm volatile("" : "+s"(pp_)); const CAS Params& P = *pp_;
        unsigned char* ws = P.ws; asm volatile("" : "+s"(ws));
        const int lane = tid & 63, wave = __builtin_amdgcn_readfirstlane(tid >> 6);
        const int gw = bid * 8 + wave, NGW = G * 8;
        float* mod = (float*)(ws + WS_MOD); const float* cs = (const float*)(ws + WS_CS);
        bf16_t* hb = (bf16_t*)(ws + WS_H); bf16_t* yb = (bf16_t*)(ws + WS_Y); bf16_t* lat = (bf16_t*)(ws + WS_LAT);
        bf16_t* cq = (bf16_t*)(ws + WS_CQ); bf16_t* ckv = (bf16_t*)(ws + WS_CKV);
        bf16_t* qb_ = (bf16_t*)(ws + WS_Q); bf16_t* kb_ = (bf16_t*)(ws + WS_K); bf16_t* vb_ = (bf16_t*)(ws + WS_V); bf16_t* big = (bf16_t*)(ws + WS_BIG);
        int njobs = 0;
        if (ph == 2 || ph == 6 || ph == 8 || ph == 9 || ph == 11 || ph == 13 || ph == 15 || ph == 16) njobs = 1; else if (ph == 4) njobs = 2;
        if (njobs) {
#pragma unroll 1
            for (int jb = 0; jb < njobs; ++jb) {
                pg8::Gemm g; pg8::EpiGen E; E.O2 = nullptr; E.cs = cs; E.scale = 1.f;
                if (ph == 2)       { g = pg8::Gemm{hb, (const bf16_t*)(ws + W_IN), MT, LATP, DM};  E.mode = 1; E.O = lat; E.ldc = LATP; }
                else if (ph == 4 && jb == 0) { g = pg8::Gemm{cq, (const bf16_t*)(ws + W_UQ), MT, NH * DQK, QL}; E.mode = 3; E.O = qb_; E.ldc = NH * DQK; E.scale = QSCALE; }
                else if (ph == 4)  { g = pg8::Gemm{ckv, (const bf16_t*)(ws + W_UKV), MT, NH * 256, KVL}; E.mode = 4; E.O = kb_; E.O2 = vb_; E.ldc = 0; }
                else if (ph == 6)  { g = pg8::Gemm{hb, (const bf16_t*)(ws + W_O), MT, DM, DM}; E.mode = 1; E.O = yb; E.ldc = DM; }
                else if (ph == 8 || ph == 15)  { const int l = ph == 15; g = pg8::Gemm{hb, (const bf16_t*)(ws + W_UP) + (size_t)l * DM * DFF, MT, DFF, DM}; E.mode = 2; E.O = big; E.ldc = DFF; }
                else if (ph == 9 || ph == 16)  { const int l = ph == 16; g = pg8::Gemm{big, (const bf16_t*)(ws + W_DN) + (size_t)l * DM * DFF, MT, DM, DFF}; E.mode = 1; E.O = yb; E.ldc = DM; }
                else if (ph == 11) { g = pg8::Gemm{hb, (const bf16_t*)(ws + W_CIN), MT, 3 * DM, DM}; E.mode = 5; E.O = big; E.O2 = big + (size_t)MT * DM; E.ldc = DM; }
                else               { g = pg8::Gemm{hb, (const bf16_t*)(ws + W_COUT), MT, DM, DM}; E.mode = 1; E.O = yb; E.ldc = DM; }
                pg8::StaticOrder S; S.init(g.M, g.N, G, bid);
                int tidj = tid; asm volatile("" : "+v"(tidj));
                pg8::gemm_phase<pg8::EpiGen, pg8::StaticOrder, true, true>(lds, g, S, E, tidj);
                __syncthreads();
                if (ph == 2) { int tid3 = tid; asm volatile("" : "+v"(tid3)); deferred_convert(P, ws, lds, tid3 & 63, __builtin_amdgcn_readfirstlane(tid3 >> 6), G, bid); }
            }
        } else if (ph == 0) {
            p0_prologue(P, ws, lds, tid, lane, wave, G, bid);
        } else if (ph == 1) {
            row_prenorm(P.x, P.norm_g, mod, 0, 1, hb, lane, gw, NGW);
        } else if (ph == 3) {
            row_latent(lat, P.mla_g_q, P.mla_g_kv, cs, cq, ckv, kb_, lane, gw, NGW);
        } else if (ph == 5) {
            const int vcu = (G % 8 == 0) ? (bid % 8) * (G / 8) + bid / 8 : bid;
            if (G == 256) { const int bh = vcu >> 2, s = vcu & 3;
#pragma unroll 1
                for (int i = 0; i < 4; ++i) { const int qb = (i == 0) ? 15 - s : (i == 1) ? 8 + s : (i == 2) ? 7 - s : s; int tid2 = tid; asm volatile("" : "+v"(tid2)); att::attn_unit(bh >> 4, bh & 15, qb, qb_, kb_, vb_, hb, lds, tid2); } }
            else {
#pragma unroll 1
                for (int u = bid; u < NB * NH * 16; u += G) { int tid2 = tid; asm volatile("" : "+v"(tid2)); att::attn_unit((u & 63) >> 4, u & 15, 15 - (u >> 6), qb_, kb_, vb_, hb, lds, tid2); } }
        } else if (ph == 12) {
            row_conv(big + (size_t)MT * DM, big, P.conv_w, hb, lane, gw, NGW);
        } else if (ph == 7 || ph == 10 || ph == 14 || ph == 17) {
            const int layer = ph >= 14, second = (ph == 10 || ph == 17);
            const float* ng = P.norm_g + (size_t)layer * 4 * DM; const float* md = mod + (size_t)layer * 4 * NMOD;
            const float* gpost = ng + (second ? 3 : 1) * DM; const float* gate = md + (second ? 5 : 2) * DM;
            bf16_t* xb = (bf16_t*)(ws + WS_XB);
            const float* gpre; const float* sc; const float* sh; bf16_t* hout = hb;
            if (!second) { gpre = ng + 2 * DM; sc = md + 4 * DM; sh = md + 3 * DM; }
            else if (layer == 0) { gpre = P.norm_g + 4 * DM; sc = mod + (size_t)4 * NMOD + 1 * DM; sh = mod + (size_t)4 * NMOD; }
            else { gpre = gpost; sc = gate; sh = gate; hout = nullptr; }
            row_resid((ph == 7) ? P.x : nullptr, xb, yb, (ph == 17) ? P.out : nullptr, xb, hout, gpost, gate, gpre, sc, sh, lane, gw, NGW);
        }
#ifdef EXTRA_SYNCS
        if (ph == 3) { for (int e = 0; e < EXTRA_SYNCS; ++e) grid.sync(); }
#endif
        if (it + 1 < it_hi) { if (P.use_cg) grid.sync(); else xcd_barrier(xbar); }
    }
}

extern "C" void kernel_launch(void* const* d_in, const int* in_sizes, int n_in, void* d_out, int out_size, void* d_ws, size_t ws_size, hipStream_t stream) {
    static int grid = 0;
    if (grid == 0) {
        if (n_in != 17 || out_size != MT * DM || ws_size < WS_END) { fprintf(stderr, "kernel_launch: unexpected problem (n_in %d, out %d, ws %zu)\n", n_in, out_size, ws_size); grid = -1; return; }
        int dev = 0, cus = 0, per_cu = 0;
        hipGetDevice(&dev); hipDeviceGetAttribute(&cus, hipDeviceAttributeMultiprocessorCount, dev);
        if (hipFuncSetAttribute((const void*)fwd_megakernel, hipFuncAttributeMaxDynamicSharedMemorySize, LDS_BYTES) != hipSuccess) { fprintf(stderr, "kernel_launch: hipFuncSetAttribute failed\n"); grid = -1; return; }
        if (hipOccupancyMaxActiveBlocksPerMultiprocessor(&per_cu, (const void*)fwd_megakernel, NTHREADS, LDS_BYTES) != hipSuccess || per_cu < 1) { fprintf(stderr, "kernel_launch: occupancy query says %d\n", per_cu); per_cu = 1; }
        (void)hipGetLastError();
        grid = cus;
        fprintf(stderr, "kernel_launch: cus %d per_cu %d grid %d ws %zu\n", cus, per_cu, grid, ws_size);
    }
    if (grid < 0) return;
    Params p{};
    p.x = (const float*)d_in[0]; p.c = (const float*)d_in[1]; p.pos = (const int*)d_in[2]; p.w_mod = (const float*)d_in[3]; p.b_mod = (const float*)d_in[4]; p.norm_g = (const float*)d_in[5];
    p.mla_w_in = (const float*)d_in[6]; p.mla_g_q = (const float*)d_in[7]; p.mla_g_kv = (const float*)d_in[8]; p.mla_w_uq = (const float*)d_in[9]; p.mla_w_ukv = (const float*)d_in[10]; p.mla_w_o = (const float*)d_in[11];
    p.conv_w_in = (const float*)d_in[12]; p.conv_w = (const float*)d_in[13]; p.conv_w_out = (const float*)d_in[14]; p.mlp_w_up = (const float*)d_in[15]; p.mlp_w_down = (const float*)d_in[16];
    p.out = (float*)d_out; p.ws = (unsigned char*)d_ws; p.ph_lo = 0; p.ph_hi = 18; p.use_cg = 0; p.pad = 0;
    if (hipMemsetAsync(d_ws, 0, 16384, stream) != hipSuccess) { fprintf(stderr, "kernel_launch: memset failed\n"); return; }
    void* args[] = {&p};
    hipError_t e = hipLaunchCooperativeKernel((const void*)fwd_megakernel, dim3(grid), dim3(NTHREADS), args, LDS_BYTES, stream);
    if (e != hipSuccess) fprintf(stderr, "kernel_launch: cooperative launch failed: %s (grid %d)\n", hipGetErrorString(e), grid);
}
```

```cpp
#include <hip/hip_runtime.h>
#include <hip/hip_cooperative_groups.h>
#include <cstdio>
#include <cstdint>
namespace cg = cooperative_groups;
namespace pg8 {
#define PG8_LAS __attribute__((address_space(3)))
typedef unsigned short bf16_t;
typedef short bf16x8 __attribute__((ext_vector_type(8)));
typedef float f32x4 __attribute__((ext_vector_type(4)));
typedef unsigned u32x4 __attribute__((ext_vector_type(4)));
constexpr int BM = 256, BK = 64, HALF = 128, HTB = HALF * BK * 2  , STAGE_BYTES = 8 * HTB, NXCD = 8, WGM = 8;

__host__ __device__ __forceinline__ int lds_byte(int r, int c) { const int st = (r >> 4) * 2 + (c >> 5), rr = r & 15, cc = c & 31, ob = rr * 64 + cc * 2; return st * 1024 + (ob ^ (((ob >> 9) & 1) << 5)); }
__host__ __device__ __forceinline__ void stage_rc(int b, int& R, int& C) { const int st = b / 1024, sb = b % 1024, swz = sb ^ (((sb >> 9) & 1) << 5); R = (st >> 1) * 16 + swz / 64; C = (st & 1) * 32 + (swz % 64) / 2; }
__host__ __device__ __forceinline__ int perm32(int rho) { const int n = rho >> 4, i = rho & 15; return 8 * (i >> 2) + 4 * n + (i & 3); }

struct Unit { int pm, pn; };
struct Gemm { const bf16_t* A; const bf16_t* Bt; int M, N, K; };

struct StaticOrder {
    int nM, nN, nwg, G, c;
    __host__ __device__ void init(int M, int N, int G_, int c_) { nM = M / BM; nN = N / BM; nwg = nM * nN; G = G_; c = c_; }
    __host__ __device__ bool next(int i, Unit& u) const {
        const long L = (long)i * G + c; if (L >= nwg) return false;
        int wgid = (int)L; { const int q = nwg / NXCD, r = nwg % NXCD, xcd = wgid % NXCD, off = wgid / NXCD; wgid = (xcd < r ? xcd * (q + 1) : r * (q + 1) + (xcd - r) * q) + off; }
        const int nig = WGM * nN, gid = wgid / nig, fm = gid * WGM, gsz = (nM - fm) < WGM ? (nM - fm) : WGM;
        u.pm = fm + ((wgid % nig) % gsz); u.pn = (wgid % nig) / gsz; return true;
    }
    __device__ __forceinline__ void a_ready(const Unit&) const {}
    __device__ __forceinline__ void done(const Unit&) const {}
};


__device__ __forceinline__ unsigned cvt_pk_bf16(float lo, float hi) { unsigned r; asm volatile("v_cvt_pk_bf16_f32 %0, %1, %2" : "=v"(r) : "v"(lo), "v"(hi)); return r; }

struct EpiGen {
    static constexpr bool PERM = true, AFTER_DRAIN = false;
    int mode;
    void* O; int ldc; void* O2; const float* cs; float scale;
    __device__ __forceinline__ void operator()(const f32x4 (&acc)[2][2][4][2], const Unit& u, int wr, int wc, int fr, int fq) const {
        int row0 = u.pm * BM + wr * 64 + fr;
        int colb = u.pn * BM + wc * 32 + 8 * fq;
        asm volatile("" : "+v"(row0), "+v"(colb));
        int mode = this->mode; asm volatile("" : "+s"(mode));
        if (mode == 0) {
            float* base = (float*)O;
#pragma unroll
            for (int ai = 0; ai < 2; ++ai)
#pragma unroll
                for (int m = 0; m < 4; ++m) { float* rowp = base + (size_t)(row0 + ai * HALF + m * 16) * ldc + colb;
#pragma unroll
                    for (int bj = 0; bj < 2; ++bj) { *(f32x4*)(rowp + bj * HALF) = acc[ai][bj][m][0]; *(f32x4*)(rowp + bj * HALF + 4) = acc[ai][bj][m][1]; } }
        } else if (mode == 5 && u.pn < 16) {
            bf16_t* base = (bf16_t*)O; const int zc = u.pn * HALF + (colb & 127);
#pragma unroll
            for (int ai = 0; ai < 2; ++ai)
#pragma unroll
                for (int m = 0; m < 4; ++m) { const f32x4 v0 = acc[ai][0][m][0] * acc[ai][1][m][0], v1 = acc[ai][0][m][1] * acc[ai][1][m][1];
                    u32x4 w; w.x = cvt_pk_bf16(v0[0], v0[1]); w.y = cvt_pk_bf16(v0[2], v0[3]); w.z = cvt_pk_bf16(v1[0], v1[1]); w.w = cvt_pk_bf16(v1[2], v1[3]);
                    *(u32x4*)(base + (size_t)(row0 + ai * HALF + m * 16) * ldc + zc) = w; }
        } else if (mode == 1 || mode == 2 || mode == 5) {
            bf16_t* base = (mode == 5) ? (bf16_t*)O2 - 16 * BM : (bf16_t*)O; const bool sq = (mode == 2);
#pragma unroll
            for (int ai = 0; ai < 2; ++ai)
#pragma unroll
                for (int m = 0; m < 4; ++m) { bf16_t* rowp = base + (size_t)(row0 + ai * HALF + m * 16) * ldc + colb;
#pragma unroll
                    for (int bj = 0; bj < 2; ++bj) { f32x4 v0 = acc[ai][bj][m][0], v1 = acc[ai][bj][m][1];
                        if (sq) {
#pragma unroll
                            for (int e = 0; e < 4; ++e) { const float a = fmaxf(v0[e], 0.f), b = fmaxf(v1[e], 0.f); v0[e] = a * a; v1[e] = b * b; } }
                        u32x4 w; w.x = cvt_pk_bf16(v0[0], v0[1]); w.y = cvt_pk_bf16(v0[2], v0[3]); w.z = cvt_pk_bf16(v1[0], v1[1]); w.w = cvt_pk_bf16(v1[2], v1[3]);
                        *(u32x4*)(rowp + bj * HALF) = w; } }
        } else if (mode == 3) {
            bf16_t* base = (bf16_t*)O;
#pragma unroll
            for (int bj = 0; bj < 2; ++bj) {
                const int col = colb + bj * HALF, d = col % 192; const bool rope = d >= 128; const int j0 = (d - 128) >> 1;
#pragma unroll
                for (int ai = 0; ai < 2; ++ai)
#pragma unroll
                    for (int m = 0; m < 4; ++m) { const int row = row0 + ai * HALF + m * 16;
                        f32x4 v0 = acc[ai][bj][m][0] * scale, v1 = acc[ai][bj][m][1] * scale;
                        if (rope) { const f32x4 c0 = *(const f32x4*)(cs + (size_t)row * 64 + 2 * j0), c1 = *(const f32x4*)(cs + (size_t)row * 64 + 2 * j0 + 4);
                            f32x4 t0, t1;
                            t0[0] = v0[0] * c0[0] - v0[1] * c0[1]; t0[1] = v0[1] * c0[0] + v0[0] * c0[1];
                            t0[2] = v0[2] * c0[2] - v0[3] * c0[3]; t0[3] = v0[3] * c0[2] + v0[2] * c0[3];
                            t1[0] = v1[0] * c1[0] - v1[1] * c1[1]; t1[1] = v1[1] * c1[0] + v1[0] * c1[1];
                            t1[2] = v1[2] * c1[2] - v1[3] * c1[3]; t1[3] = v1[3] * c1[2] + v1[2] * c1[3];
                            v0 = t0; v1 = t1; }
                        u32x4 w; w.x = cvt_pk_bf16(v0[0], v0[1]); w.y = cvt_pk_bf16(v0[2], v0[3]); w.z = cvt_pk_bf16(v1[0], v1[1]); w.w = cvt_pk_bf16(v1[2], v1[3]);
                        *(u32x4*)(base + (size_t)row * ldc + col) = w; } }
        } else {
            bf16_t* kb = (bf16_t*)O; bf16_t* vb = (bf16_t*)O2; const int h = u.pn, dcol = colb & 127;
#pragma unroll
            for (int ai = 0; ai < 2; ++ai)
#pragma unroll
                for (int m = 0; m < 4; ++m) { const size_t row = (size_t)(row0 + ai * HALF + m * 16);
#pragma unroll
                    for (int bj = 0; bj < 2; ++bj) { const f32x4 v0 = acc[ai][bj][m][0], v1 = acc[ai][bj][m][1];
                        u32x4 w; w.x = cvt_pk_bf16(v0[0], v0[1]); w.y = cvt_pk_bf16(v0[2], v0[3]); w.z = cvt_pk_bf16(v1[0], v1[1]); w.w = cvt_pk_bf16(v1[2], v1[3]);
                        if (bj == 0) *(u32x4*)(kb + (row * 16 + h) * 192 + dcol) = w; else *(u32x4*)(vb + row * 2048 + h * 128 + dcol) = w; } }
        }
    }
};

template <class Epi, class Sched, bool ALIGN_EPI = false, bool SP2 = false>
__device__ __forceinline__ void gemm_phase(PG8_LAS unsigned char* lds, const Gemm g, const Sched& S, const Epi& E, const int tid) {
    const int wid = __builtin_amdgcn_readfirstlane(tid >> 6), lane = tid & 63, wr = wid >> 2, wc = wid & 3, fr = lane & 15, fq = lane >> 4;
    const int K = g.K, nt = K / BK;
    unsigned voffA[2], voffB[2];
#pragma unroll
    for (int i = 0; i < 2; ++i) { int R, C; stage_rc(tid * 16 + i * 8192, R, C); const int Rb = Epi::PERM ? ((R & ~31) + perm32(R & 31)) : R;
        voffA[i] = (unsigned)(R * K + C) * 2u; voffB[i] = (unsigned)(Rb * K + C) * 2u; }
    const size_t kstep = (size_t)(BK * 2);
    const size_t hstep = (size_t)HALF * K * 2;
    const size_t tstep = 2 * hstep;
    const unsigned ldsw = (unsigned)wid * 1024u;
    const int aoff = lds_byte(wr * 64 + fr, fq * 8), boff = lds_byte(wc * 32 + fr, fq * 8);
#define PG8_SA(b, h) (((b) * 2 + (h)) * HTB)
#define PG8_SB(b, h) ((4 + (b) * 2 + (h)) * HTB)
#define PG8_STAGE(bufoff, gbase, voff) do { _Pragma("unroll") for (int _i = 0; _i < 2; ++_i) \
        __builtin_amdgcn_global_load_lds((const unsigned*)((const char*)(gbase) + (voff)[_i]), (PG8_LAS unsigned*)(lds + (bufoff) + ldsw + _i * 8192), 16, 0, 0); } while (0)
#define PG8_LDA(dst, b, h) do { _Pragma("unroll") for (int m = 0; m < 4; ++m) _Pragma("unroll") for (int k = 0; k < 2; ++k) dst[m][k] = *(const PG8_LAS bf16x8*)(lds + PG8_SA(b, h) + aoff + m * 2048 + k * 1024); } while (0)
#define PG8_LDB(dst, b, h) do { _Pragma("unroll") for (int n = 0; n < 2; ++n) _Pragma("unroll") for (int k = 0; k < 2; ++k) dst[n][k] = *(const PG8_LAS bf16x8*)(lds + PG8_SB(b, h) + boff + n * 2048 + k * 1024); } while (0)
#define PG8_MMA(ai, bj, At, Bt) do { __builtin_amdgcn_s_setprio(1); _Pragma("unroll") for (int m = 0; m < 4; ++m) _Pragma("unroll") for (int n = 0; n < 2; ++n) _Pragma("unroll") for (int k = 0; k < 2; ++k) \
        acc[ai][bj][m][n] = __builtin_amdgcn_mfma_f32_16x16x32_bf16(Bt[n][k], At[m][k], acc[ai][bj][m][n], 0, 0, 0); __builtin_amdgcn_s_setprio(0); } while (0)
#define PG8_WAIT_V(n) asm volatile("s_waitcnt vmcnt(" #n ")" ::: "memory")
#define PG8_WAIT_L(n) asm volatile("s_waitcnt lgkmcnt(" #n ")" ::: "memory")
#define PG8_BAR __builtin_amdgcn_s_barrier()
#define PG8_SCHED __builtin_amdgcn_sched_barrier(0)
    Unit cur, nxt; int ui = 0;
    if (!S.next(0, cur)) return;
    f32x4 acc[2][2][4][2];
#pragma unroll
    for (int a = 0; a < 2; ++a)
#pragma unroll
        for (int b = 0; b < 2; ++b)
#pragma unroll
            for (int m = 0; m < 4; ++m)
#pragma unroll
                for (int n = 0; n < 2; ++n) acc[a][b][m][n] = (f32x4){0.f, 0.f, 0.f, 0.f};
    bf16x8 At[4][2], B0[2][2], B1[2][2];
    const char* cA = (const char*)g.A + (size_t)cur.pm * tstep; const char* cB = (const char*)g.Bt + (size_t)cur.pn * tstep;
    S.a_ready(cur);
    if constexpr (SP2) {
        PG8_STAGE(PG8_SB(0, 0), cB, voffB); PG8_STAGE(PG8_SB(0, 1), cB + hstep, voffB); PG8_STAGE(PG8_SA(0, 0), cA, voffA); PG8_STAGE(PG8_SA(0, 1), cA + hstep, voffA);
        if (wr == 1) PG8_BAR;
        PG8_WAIT_V(2); PG8_BAR;
        PG8_STAGE(PG8_SB(1, 0), cB + kstep, voffB); PG8_STAGE(PG8_SA(1, 0), cA + kstep, voffA); PG8_STAGE(PG8_SB(1, 1), cB + hstep + kstep, voffB);
        PG8_WAIT_V(6); PG8_BAR;
    } else {
        PG8_STAGE(PG8_SB(0, 0), cB, voffB); PG8_STAGE(PG8_SA(0, 0), cA, voffA); PG8_STAGE(PG8_SB(0, 1), cB + hstep, voffB); PG8_STAGE(PG8_SA(0, 1), cA + hstep, voffA);
        if (wr == 1) PG8_BAR;
        PG8_WAIT_V(4); PG8_BAR;
        PG8_STAGE(PG8_SB(1, 0), cB + kstep, voffB); PG8_STAGE(PG8_SA(1, 0), cA + kstep, voffA); PG8_STAGE(PG8_SB(1, 1), cB + hstep + kstep, voffB);
        PG8_WAIT_V(6); PG8_BAR;
    }
    for (;;) {
        const bool has_next = S.next(ui + 1, nxt);
        const char* nA = has_next ? (const char*)g.A + (size_t)nxt.pm * tstep : cA; const char* nB = has_next ? (const char*)g.Bt + (size_t)nxt.pn * tstep : cB;
        for (int t = 0; t < nt; t += 2) {
            const bool last = (t == nt - 2);
            const char* a1 = cA + (size_t)(t + 1) * kstep;
            const char* a2 = last ? nA : cA + (size_t)(t + 2) * kstep; const char* b2 = last ? nB : cB + (size_t)(t + 2) * kstep;
            const char* a3 = a2 + kstep; const char* b3 = b2 + kstep;
            if (last && has_next) S.a_ready(nxt);
            if constexpr (SP2) {
            PG8_LDB(B0, 0, 0); PG8_LDB(B1, 0, 1); PG8_SCHED; PG8_LDA(At, 0, 0); PG8_STAGE(PG8_SA(1, 1), a1 + hstep, voffA);
            PG8_WAIT_V(8); PG8_WAIT_L(0); PG8_BAR; PG8_MMA(0, 0, At, B0); PG8_MMA(0, 1, At, B1); PG8_BAR; PG8_SCHED;
            PG8_LDA(At, 0, 1); PG8_STAGE(PG8_SB(0, 0), b2, voffB); PG8_STAGE(PG8_SB(0, 1), b2 + hstep, voffB); PG8_STAGE(PG8_SA(0, 0), a2, voffA);
            PG8_WAIT_V(8); PG8_WAIT_L(0); PG8_BAR; PG8_MMA(1, 0, At, B0); PG8_MMA(1, 1, At, B1); PG8_BAR; PG8_SCHED;
            PG8_LDB(B0, 1, 0); PG8_LDB(B1, 1, 1); PG8_SCHED; PG8_LDA(At, 1, 0); PG8_STAGE(PG8_SA(0, 1), a2 + hstep, voffA);
            PG8_WAIT_V(8); PG8_WAIT_L(0); PG8_BAR; PG8_MMA(0, 0, At, B0); PG8_MMA(0, 1, At, B1); PG8_BAR; PG8_SCHED;
            PG8_LDA(At, 1, 1); PG8_STAGE(PG8_SB(1, 0), b3, voffB); PG8_STAGE(PG8_SB(1, 1), b3 + hstep, voffB); PG8_STAGE(PG8_SA(1, 0), a3, voffA);
            PG8_WAIT_V(8); PG8_WAIT_L(0); PG8_BAR; PG8_MMA(1, 0, At, B0); PG8_MMA(1, 1, At, B1); PG8_BAR; PG8_SCHED;
            } else {
            PG8_LDB(B0, 0, 0); PG8_SCHED; PG8_LDA(At, 0, 0); PG8_STAGE(PG8_SA(1, 1), a1 + hstep, voffA);
            PG8_WAIT_L(8); PG8_BAR; PG8_WAIT_L(0); PG8_MMA(0, 0, At, B0); PG8_BAR; PG8_SCHED;
            PG8_LDB(B1, 0, 1); PG8_STAGE(PG8_SB(0, 0), b2, voffB);
            PG8_BAR; PG8_WAIT_L(0); PG8_MMA(0, 1, At, B1); PG8_BAR;
            PG8_LDA(At, 0, 1); PG8_STAGE(PG8_SA(0, 0), a2, voffA);
            PG8_BAR; PG8_WAIT_L(0); PG8_MMA(1, 0, At, B0); PG8_BAR; PG8_SCHED;
            PG8_STAGE(PG8_SB(0, 1), b2 + hstep, voffB);
            PG8_WAIT_V(6); PG8_BAR; PG8_MMA(1, 1, At, B1); PG8_BAR;
            PG8_LDB(B0, 1, 0); PG8_SCHED; PG8_LDA(At, 1, 0); PG8_STAGE(PG8_SA(0, 1), a2 + hstep, voffA);
            PG8_WAIT_L(8); PG8_BAR; PG8_WAIT_L(0); PG8_MMA(0, 0, At, B0); PG8_BAR; PG8_SCHED;
            PG8_LDB(B1, 1, 1); PG8_STAGE(PG8_SB(1, 0), b3, voffB);
            PG8_BAR; PG8_WAIT_L(0); PG8_MMA(0, 1, At, B1); PG8_BAR;
            PG8_LDA(At, 1, 1); PG8_STAGE(PG8_SA(1, 0), a3, voffA);
            PG8_BAR; PG8_WAIT_L(0); PG8_MMA(1, 0, At, B0); PG8_BAR; PG8_SCHED;
            PG8_STAGE(PG8_SB(1, 1), b3 + hstep, voffB);
            PG8_WAIT_V(6); PG8_BAR; PG8_MMA(1, 1, At, B1); PG8_BAR;
            }
        }
        if constexpr (ALIGN_EPI) { if (wr == 0) PG8_BAR; }
        if constexpr (!Epi::AFTER_DRAIN) { E(acc, cur, wr, wc, fr, fq); S.done(cur); }
        if (!has_next) break;
#pragma unroll
        for (int a = 0; a < 2; ++a)
#pragma unroll
            for (int b = 0; b < 2; ++b)
#pragma unroll
                for (int m = 0; m < 4; ++m)
#pragma unroll
                    for (int n = 0; n < 2; ++n) acc[a][b][m][n] = (f32x4){0.f, 0.f, 0.f, 0.f};
        cur = nxt; cA = nA; cB = nB; ++ui;
        if constexpr (ALIGN_EPI) { if (wr == 1) PG8_BAR; }
    }
    PG8_WAIT_V(0);
    if constexpr (!ALIGN_EPI) { if (wr == 0) PG8_BAR; }
    PG8_BAR;
    if constexpr (Epi::AFTER_DRAIN) { E.fused(acc, cur, wr, wc, fr, fq, lds, wid, lane); S.done(cur); }
#undef PG8_SA
#undef PG8_SB
#undef PG8_STAGE
#undef PG8_LDA
#undef PG8_LDB
#undef PG8_MMA
#undef PG8_WAIT_V
#undef PG8_WAIT_L
#undef PG8_BAR
#undef PG8_SCHED
}
}

#define LAS __attribute__((address_space(3)))
typedef unsigned short bf16_t;
typedef short bf16x8 __attribute__((ext_vector_type(8)));
typedef short s16x4 __attribute__((ext_vector_type(4)));
typedef float f32x4 __attribute__((ext_vector_type(4)));
typedef float f32x16 __attribute__((ext_vector_type(16)));
typedef unsigned u32x4 __attribute__((ext_vector_type(4)));
typedef unsigned u32x2 __attribute__((ext_vector_type(2)));

constexpr int DM = 2048, NB = 4, SEQ = 4096, MT = NB * SEQ, NH = 16, DQK = 192, DV = 128, QL = 512, KVL = 512, LATP = 1280, LATN = 1088, DFF = 8192, NMOD = 6 * DM;
constexpr float EPS = 1e-6f;
constexpr size_t MiB = 1u << 20;
constexpr size_t WS_MOD = 1 * MiB, WS_CS = 2 * MiB;
constexpr size_t W_IN = 8 * MiB, W_UQ = 13 * MiB, W_UKV = 16 * MiB, W_O = 20 * MiB, W_CIN = 28 * MiB, W_COUT = 52 * MiB, W_UP = 60 * MiB, W_DN = 124 * MiB;
constexpr size_t WS_H = 192 * MiB, WS_Y = 256 * MiB, WS_LAT = 256 * MiB, WS_CQ = 336 * MiB, WS_CKV = 352 * MiB;
constexpr size_t WS_BIG = 384 * MiB, WS_Q = 384 * MiB, WS_K = 480 * MiB, WS_V = 576 * MiB, WS_XB = 640 * MiB, WS_END = 704 * MiB;
constexpr int LDS_BYTES = 139264;
constexpr int NTHREADS = 512;

__device__ __forceinline__ unsigned pk2(float lo, float hi) { typedef float f2 __attribute__((ext_vector_type(2))); typedef __bf16 b2 __attribute__((ext_vector_type(2))); f2 v = {lo, hi}; b2 b = __builtin_convertvector(v, b2); return __builtin_bit_cast(unsigned, b); }
__device__ __forceinline__ float bflo(unsigned w) { return __uint_as_float(w << 16); }
__device__ __forceinline__ float bfhi(unsigned w) { return __uint_as_float(w & 0xffff0000u); }
__device__ __forceinline__ float shx(float v, int mask, int lane) { return __int_as_float(__builtin_amdgcn_ds_bpermute((lane ^ mask) << 2, __float_as_int(v))); }
__device__ __forceinline__ float wave_sum(float v, int lane) {
#pragma unroll
    for (int o = 32; o >= 1; o >>= 1) v += shx(v, o, lane);
    return v;
}

#define CAS __attribute__((address_space(4)))
struct Params {
    const float* x; const float* c; const int* pos; const float* w_mod; const float* b_mod; const float* norm_g;
    const float* mla_w_in; const float* mla_g_q; const float* mla_g_kv; const float* mla_w_uq; const float* mla_w_ukv; const float* mla_w_o;
    const float* conv_w_in; const float* conv_w; const float* conv_w_out; const float* mlp_w_up; const float* mlp_w_down;
    float* out; unsigned char* ws; int ph_lo, ph_hi, use_cg, pad;
};

__device__ __forceinline__ void transpose_item(const float* __restrict__ W, int K, int N, bf16_t* __restrict__ WT, int qperm  , LAS float* scr, int item, int lane) {
    const int nblk = N / 64, kb = item / nblk, nb = item % nblk, k0 = 64 * kb, n0 = 64 * nb;
    f32x4 v[16];
    const float* src = W + (size_t)(k0 + (lane >> 4)) * N + n0 + 4 * (lane & 15);
#pragma unroll
    for (int i = 0; i < 16; ++i) v[i] = __builtin_nontemporal_load((const f32x4*)(src + (size_t)(4 * i) * N));
#pragma unroll
    for (int i = 0; i < 16; ++i) { LAS float* d = scr + (4 * i + (lane >> 4)) * 65 + 4 * (lane & 15); d[0] = v[i][0]; d[1] = v[i][1]; d[2] = v[i][2]; d[3] = v[i][3]; }
    asm volatile("s_waitcnt lgkmcnt(0)" ::: "memory");
    const int c = lane & 7;
#pragma unroll
    for (int j = 0; j < 8; ++j) { const int n = (lane >> 3) + 8 * j; const LAS float* s = scr + (8 * c) * 65 + n;
        u32x4 o; o.x = pk2(s[0 * 65], s[1 * 65]); o.y = pk2(s[2 * 65], s[3 * 65]); o.z = pk2(s[4 * 65], s[5 * 65]); o.w = pk2(s[6 * 65], s[7 * 65]);
        int nr = n0 + n;
        if (qperm == 1) { const int hh = nr / 192, d = nr % 192; if (d >= 128) { const int j2 = d - 128; nr = hh * 192 + 128 + ((j2 < 32) ? 2 * j2 : 2 * (j2 - 32) + 1); } }
        else if (qperm == 2) { if (nr < DM) nr += 2 * DM; else { const int u_ = nr >= 2 * DM, ch = nr - (u_ ? 2 * DM : DM); nr = (ch >> 7) * 256 + u_ * 128 + (ch & 127); } }
        *(u32x4*)(WT + (size_t)nr * K + k0 + 8 * c) = o; }
    asm volatile("s_waitcnt lgkmcnt(0)" ::: "memory");
}

__device__ __forceinline__ float inv_freq_f(int j) {
    const int a = j >> 3, b = j & 7;
    const float fb = b == 0 ? 1.0f : b == 1 ? 0.7498942093324559f : b == 2 ? 0.5623413251903491f : b == 3 ? 0.4216965034285822f : b == 4 ? 0.31622776601683794f : b == 5 ? 0.23713737056616552f : b == 6 ? 0.1778279410038923f : 0.1333521432163324f;
    const float fa = a == 0 ? 1.0f : a == 1 ? 0.1f : a == 2 ? 0.01f : 0.001f;
    return fa * fb;
}
__device__ __forceinline__ void sincos_acc(float angf, float& c, float& s) {
    const double ang = (double)angf;
    const double n = __builtin_rint(ang * 0.6366197723675814);
    double rd = __builtin_fma(-n, 1.5707963267948966, ang); rd = __builtin_fma(-n, 6.123233995736766e-17, rd);
    const float r = (float)rd, z = r * r;
    const float sr = r + r * z * (-1.6666654611e-1f + z * (8.3321608736e-3f + z * -1.9515295891e-4f));
    const float cr = 1.0f - 0.5f * z + z * z * (4.166664568298827e-2f + z * (-1.388731625493765e-3f + z * 2.443315711809948e-5f));
    const int q = ((int)n) & 3;
    s = (q == 0) ? sr : (q == 1) ? cr : (q == 2) ? -sr : -cr;
    c = (q == 0) ? cr : (q == 1) ? -sr : (q == 2) ? -cr : sr;
}

__device__ __forceinline__ void p0_prologue(const CAS Params& P, unsigned char* ws, LAS unsigned char* lds, int tid, int lane, int wave, int G, int bid) {
    float* mod = (float*)(ws + WS_MOD); float* cs = (float*)(ws + WS_CS);
    for (int i = bid * NTHREADS + tid; i < MT * 32; i += G * NTHREADS) { const int t = i >> 5, j = i & 31;
        const float ang = (float)P.pos[t] * inv_freq_f(j); float c_, s_; sincos_acc(ang, c_, s_); cs[2 * i] = c_; cs[2 * i + 1] = s_; }
    LAS float* condL = (LAS float*)lds; LAS float* red = (LAS float*)(lds + 32768);
    for (int i = tid; i < NB * DM; i += NTHREADS) { const float v = P.c[i]; condL[i] = v / (1.f + __expf(-v)); }
    __syncthreads();
    for (int unit = bid; unit < 2 * (NMOD / 32); unit += G) {
        const int layer = unit / (NMOD / 32), cb = unit % (NMOD / 32);
        const float* W = P.w_mod + (size_t)layer * DM * NMOD + cb * 32 + 4 * (lane & 7);
        const int kph = wave * 8 + (lane >> 3);
        f32x4 acc[4];
#pragma unroll
        for (int b = 0; b < 4; ++b) acc[b] = (f32x4){0.f, 0.f, 0.f, 0.f};
#pragma unroll 16
        for (int kk = 0; kk < 32; ++kk) { const int k = kph + 64 * kk; const f32x4 w = __builtin_nontemporal_load((const f32x4*)(W + (size_t)k * NMOD));
#pragma unroll
            for (int b = 0; b < 4; ++b) acc[b] += w * condL[b * DM + k]; }
#pragma unroll
        for (int b = 0; b < 4; ++b) *(LAS f32x4*)(red + ((kph * 4 + b) * 32 + 4 * (lane & 7))) = acc[b];
        __syncthreads();
        if (tid < 128) { const int b = tid >> 5, cc = tid & 31; float s = 0.f;
#pragma unroll 8
            for (int kp = 0; kp < 64; ++kp) s += red[(kp * 4 + b) * 32 + cc];
            mod[(size_t)(layer * 4 + b) * NMOD + cb * 32 + cc] = s + P.b_mod[layer * NMOD + cb * 32 + cc]; }
        __syncthreads();
    }
    LAS float* scr = (LAS float*)(lds + wave * 16640);
    const int gw = bid * 8 + wave, NGW = G * 8;
    constexpr int I_IN = (DM / 64) * (LATN / 64), I_UQ = (QL / 64) * (NH * DQK / 64), I_UKV = (KVL / 64) * (NH * 256 / 64), I_O = (DM / 64) * (DM / 64),
                  I_CIN = (DM / 64) * (3 * DM / 64), I_UP = (DM / 64) * (DFF / 64), I_DN = (DFF / 64) * (DM / 64);
    constexpr int NITEMS = I_IN + I_UQ + I_UKV + I_O + I_CIN + I_O + 2 * I_UP + I_DN;
    for (int it = gw; it < NITEMS; it += NGW) {
        int r = it;
        if (r < I_IN) { transpose_item(P.mla_w_in, DM, LATN, (bf16_t*)(ws + W_IN), 0, scr, r, lane); continue; } r -= I_IN;
        if (r < I_UQ) { transpose_item(P.mla_w_uq, QL, NH * DQK, (bf16_t*)(ws + W_UQ), 1, scr, r, lane); continue; } r -= I_UQ;
        if (r < I_UKV) { transpose_item(P.mla_w_ukv, KVL, NH * 256, (bf16_t*)(ws + W_UKV), 0, scr, r, lane); continue; } r -= I_UKV;
        if (r < I_O) { transpose_item(P.mla_w_o, DM, DM, (bf16_t*)(ws + W_O), 0, scr, r, lane); continue; } r -= I_O;
        if (r < I_CIN) { transpose_item(P.conv_w_in, DM, 3 * DM, (bf16_t*)(ws + W_CIN), 2, scr, r, lane); continue; } r -= I_CIN;
        if (r < I_O) { transpose_item(P.conv_w_out, DM, DM, (bf16_t*)(ws + W_COUT), 0, scr, r, lane); continue; } r -= I_O;
        if (r < 2 * I_UP) { const int l = r / I_UP; transpose_item(P.mlp_w_up + (size_t)l * DM * DFF, DM, DFF, (bf16_t*)(ws + W_UP) + (size_t)l * DM * DFF, 0, scr, r % I_UP, lane); continue; } r -= 2 * I_UP;
        { transpose_item(P.mlp_w_down, DFF, DM, (bf16_t*)(ws + W_DN), 0, scr, r, lane); }
    }
}

__device__ __forceinline__ void deferred_convert(const CAS Params& P, unsigned char* ws, LAS unsigned char* lds, int lane, int wave, int G, int bid) {
    constexpr int I_DN = (DFF / 64) * (DM / 64);
    const int nwg = (MT / 256) * (LATP / 256), rounds = (nwg + G - 1) / G, nlight = rounds * G - nwg, first_light = G - nlight;
    int gwl, ngwl;
    if (nlight > 0) { if (bid < first_light) return; gwl = (bid - first_light) * 8 + wave; ngwl = nlight * 8; } else { gwl = bid * 8 + wave; ngwl = G * 8; }
    LAS float* scr = (LAS float*)(lds + wave * 16640);
    for (int it = gwl; it < I_DN; it += ngwl) transpose_item(P.mlp_w_down + (size_t)DM * DFF, DFF, DM, (bf16_t*)(ws + W_DN) + (size_t)DM * DFF, 0, scr, it, lane);
}

__device__ __forceinline__ void row_prenorm(const float* __restrict__ x, const float* __restrict__ g, const float* __restrict__ modl  , int shi, int sci, bf16_t* __restrict__ h, int lane, int gw, int NGW) {
    for (int m0 = gw * 8; m0 < MT; m0 += NGW * 8) {
        const int b = m0 / SEQ; const float* md = modl + (size_t)b * NMOD;
        f32x4 A[8], B[8];
#pragma unroll
        for (int j = 0; j < 8; ++j) { const int c = 4 * lane + 256 * j; const f32x4 gg = *(const f32x4*)(g + c), sc = *(const f32x4*)(md + sci * DM + c); A[j] = gg * (sc + 1.f); B[j] = *(const f32x4*)(md + shi * DM + c); }
#pragma unroll 1
        for (int r = 0; r < 8; ++r) { const size_t row = (size_t)(m0 + r);
            f32x4 v[8]; float ss = 0.f;
#pragma unroll
            for (int j = 0; j < 8; ++j) { v[j] = *(const f32x4*)(x + row * DM + 4 * lane + 256 * j); ss += (v[j][0] * v[j][0] + v[j][1] * v[j][1]) + (v[j][2] * v[j][2] + v[j][3] * v[j][3]); }
            const float rstd = 1.0f / sqrtf(wave_sum(ss, lane) * (1.0f / DM) + EPS);
#pragma unroll
            for (int j = 0; j < 8; ++j) { const f32x4 o = v[j] * rstd * A[j] + B[j]; u32x2 w; w.x = pk2(o[0], o[1]); w.y = pk2(o[2], o[3]); *(u32x2*)(h + row * DM + 4 * lane + 256 * j) = w; }
        }
    }
}
__device__ __forceinline__ void row_resid(const float* __restrict__ xin_f, const bf16_t* xin_b, const bf16_t* __restrict__ y, float* __restrict__ xout_f, bf16_t* xout_b, bf16_t* __restrict__ h,
                                          const float* __restrict__ gpost, const float* __restrict__ gate  , const float* __restrict__ gpre, const float* __restrict__ sc, const float* __restrict__ sh,
                                          int lane, int gw, int NGW) {
    for (int m0 = gw * 8; m0 < MT; m0 += NGW * 8) {
        const int b = m0 / SEQ;
        f32x4 Gv[8];
#pragma unroll
        for (int j = 0; j < 8; ++j) { const int c = 4 * lane + 256 * j; Gv[j] = *(const f32x4*)(gpost + c) * *(const f32x4*)(gate + (size_t)b * NMOD + c); }
#pragma unroll 1
        for (int r = 0; r < 8; ++r) { const size_t row = (size_t)(m0 + r);
            f32x4 v[8], xv[8]; float ss = 0.f;
#pragma unroll
            for (int j = 0; j < 8; ++j) { const u32x2 yw = *(const u32x2*)(y + row * DM + 4 * lane + 256 * j); v[j] = (f32x4){bflo(yw.x), bfhi(yw.x), bflo(yw.y), bfhi(yw.y)};
                ss += (v[j][0] * v[j][0] + v[j][1] * v[j][1]) + (v[j][2] * v[j][2] + v[j][3] * v[j][3]); }
            if (xin_f) {
#pragma unroll
                for (int j = 0; j < 8; ++j) xv[j] = *(const f32x4*)(xin_f + row * DM + 4 * lane + 256 * j);
            } else {
#pragma unroll
                for (int j = 0; j < 8; ++j) { const u32x2 xw = *(const u32x2*)(xin_b + row * DM + 4 * lane + 256 * j); xv[j] = (f32x4){bflo(xw.x), bfhi(xw.x), bflo(xw.y), bfhi(xw.y)}; }
            }
            const float rstd = 1.0f / sqrtf(wave_sum(ss, lane) * (1.0f / DM) + EPS);
            float s2 = 0.f;
#pragma unroll
            for (int j = 0; j < 8; ++j) { xv[j] = xv[j] + v[j] * rstd * Gv[j]; s2 += (xv[j][0] * xv[j][0] + xv[j][1] * xv[j][1]) + (xv[j][2] * xv[j][2] + xv[j][3] * xv[j][3]); }
            if (xout_f) {
#pragma unroll
                for (int j = 0; j < 8; ++j) *(f32x4*)(xout_f + row * DM + 4 * lane + 256 * j) = xv[j];
            } else {
#pragma unroll
                for (int j = 0; j < 8; ++j) { u32x2 w; w.x = pk2(xv[j][0], xv[j][1]); w.y = pk2(xv[j][2], xv[j][3]); *(u32x2*)(xout_b + row * DM + 4 * lane + 256 * j) = w; }
            }
            if (h) { const float rs2 = 1.0f / sqrtf(wave_sum(s2, lane) * (1.0f / DM) + EPS);
#pragma unroll
                for (int j = 0; j < 8; ++j) { const int c = 4 * lane + 256 * j;
                    const f32x4 A = *(const f32x4*)(gpre + c) * (*(const f32x4*)(sc + (size_t)b * NMOD + c) + 1.f), B = *(const f32x4*)(sh + (size_t)b * NMOD + c);
                    const f32x4 o = xv[j] * rs2 * A + B; u32x2 w; w.x = pk2(o[0], o[1]); w.y = pk2(o[2], o[3]); *(u32x2*)(h + row * DM + c) = w; } }
        }
    }
}
__device__ __forceinline__ void row_latent(const bf16_t* __restrict__ lat, const float* __restrict__ gq, const float* __restrict__ gkv, const float* __restrict__ cs,
                                           bf16_t* __restrict__ cq, bf16_t* __restrict__ ckv, bf16_t* __restrict__ Kb, int lane, int gw, int NGW) {
    for (int row = gw; row < MT; row += NGW) { const bf16_t* lr = lat + (size_t)row * LATP;
#pragma unroll
        for (int part = 0; part < 2; ++part) { const bf16_t* src = lr + part * 512; const float* gg = part ? gkv : gq; bf16_t* dst = (part ? ckv : cq) + (size_t)row * 512;
            const u32x2 r0 = *(const u32x2*)(src + 4 * lane), r1 = *(const u32x2*)(src + 256 + 4 * lane);
            const f32x4 a0 = {bflo(r0.x), bfhi(r0.x), bflo(r0.y), bfhi(r0.y)}, a1 = {bflo(r1.x), bfhi(r1.x), bflo(r1.y), bfhi(r1.y)};
            const float ss = (a0[0] * a0[0] + a0[1] * a0[1]) + (a0[2] * a0[2] + a0[3] * a0[3]) + (a1[0] * a1[0] + a1[1] * a1[1]) + (a1[2] * a1[2] + a1[3] * a1[3]);
            const float rstd = 1.0f / sqrtf(wave_sum(ss, lane) * (1.0f / 512.f) + EPS);
            const f32x4 o0 = a0 * rstd * *(const f32x4*)(gg + 4 * lane), o1 = a1 * rstd * *(const f32x4*)(gg + 256 + 4 * lane);
            u32x2 w0, w1; w0.x = pk2(o0[0], o0[1]); w0.y = pk2(o0[2], o0[3]); w1.x = pk2(o1[0], o1[1]); w1.y = pk2(o1[2], o1[3]);
            *(u32x2*)(dst + 4 * lane) = w0; *(u32x2*)(dst + 256 + 4 * lane) = w1; }
        if (lane < 32) { const float x1 = __uint_as_float((unsigned)lr[1024 + lane] << 16), x2 = __uint_as_float((unsigned)lr[1056 + lane] << 16), c_ = cs[(size_t)row * 64 + 2 * lane], s_ = cs[(size_t)row * 64 + 2 * lane + 1];
            const unsigned w = pk2(x1 * c_ - x2 * s_, x2 * c_ + x1 * s_);
#pragma unroll
            for (int hh = 0; hh < NH; ++hh) *(unsigned*)(Kb + ((size_t)row * NH + hh) * DQK + 128 + 2 * lane) = w; }
    }
}
__device__ __forceinline__ void row_conv(const bf16_t* __restrict__ bb, const bf16_t* __restrict__ zz, const float* __restrict__ cw, bf16_t* __restrict__ gz, int lane, int gw, int NGW) {
    for (int m0 = gw * 8; m0 < MT; m0 += NGW * 8) {
        const int s0 = m0 % SEQ;
#pragma unroll 1
        for (int j = 0; j < 4; ++j) { const int c0 = 8 * lane + 512 * j;
            float w0[8], w1[8], w2[8], zm2[8], zm1[8];
            { const f32x4 a = *(const f32x4*)(cw + c0), b = *(const f32x4*)(cw + c0 + 4), c = *(const f32x4*)(cw + DM + c0), d = *(const f32x4*)(cw + DM + c0 + 4), e = *(const f32x4*)(cw + 2 * DM + c0), f = *(const f32x4*)(cw + 2 * DM + c0 + 4);
#pragma unroll
              for (int i = 0; i < 4; ++i) { w0[i] = a[i]; w0[4 + i] = b[i]; w1[i] = c[i]; w1[4 + i] = d[i]; w2[i] = e[i]; w2[4 + i] = f[i]; } }
#pragma unroll
            for (int i = 0; i < 8; ++i) { zm2[i] = 0.f; zm1[i] = 0.f; }
            if (s0 >= 2) { const u32x4 za = *(const u32x4*)(zz + (size_t)(m0 - 2) * DM + c0), zb = *(const u32x4*)(zz + (size_t)(m0 - 1) * DM + c0);
#pragma unroll
                for (int i = 0; i < 4; ++i) { zm2[2 * i] = bflo(za[i]); zm2[2 * i + 1] = bfhi(za[i]); zm1[2 * i] = bflo(zb[i]); zm1[2 * i + 1] = bfhi(zb[i]); } }
#pragma unroll
            for (int r = 0; r < 8; ++r) { const size_t off = (size_t)(m0 + r) * DM + c0; const u32x4 bv = *(const u32x4*)(bb + off), zv = *(const u32x4*)(zz + off);
                float z[8], o[8];
#pragma unroll
                for (int i = 0; i < 4; ++i) { z[2 * i] = bflo(zv[i]); z[2 * i + 1] = bfhi(zv[i]); }
#pragma unroll
                for (int i = 0; i < 4; ++i) { o[2 * i] = bflo(bv[i]) * (w0[2 * i] * zm2[2 * i] + w1[2 * i] * zm1[2 * i] + w2[2 * i] * z[2 * i]); o[2 * i + 1] = bfhi(bv[i]) * (w0[2 * i + 1] * zm2[2 * i + 1] + w1[2 * i + 1] * zm1[2 * i + 1] + w2[2 * i + 1] * z[2 * i + 1]); }
                u32x4 w; w.x = pk2(o[0], o[1]); w.y = pk2(o[2], o[3]); w.z = pk2(o[4], o[5]); w.w = pk2(o[6], o[7]);
                *(u32x4*)(gz + off) = w;
#pragma unroll
                for (int i = 0; i < 8; ++i) { zm2[i] = zm1[i]; zm1[i] = z[i]; } }
        }
    }
}

namespace att {
constexpr int KSTR = 400, VSTR = 320, KT_BYTES = 64 * KSTR, VT_BYTES = 64 * VSTR, STG = KT_BYTES + VT_BYTES, NSTG = 3;
static_assert(NSTG * STG <= 138240, "attention LDS");
#define GAS __attribute__((address_space(1)))
#define ABAR() do { asm volatile("s_waitcnt lgkmcnt(0)" ::: "memory"); __builtin_amdgcn_s_barrier(); asm volatile("" ::: "memory"); } while (0)
#define MFMA32(a, b, c) __builtin_amdgcn_mfma_f32_32x32x16_bf16((a), (b), (c), 0, 0, 0)
__device__ __forceinline__ float max3f(float a, float b, float c) { float r; asm("v_max3_f32 %0, %1, %2, %3" : "=v"(r) : "v"(a), "v"(b), "v"(c)); return r; }
__device__ __forceinline__ s16x4 vtr(const LAS unsigned char* p) { typedef short v4i16_t __attribute__((ext_vector_type(4))); return __builtin_bit_cast(s16x4, __builtin_amdgcn_ds_read_tr16_b64_v4i16((LAS v4i16_t*)p)); }
__device__ __forceinline__ bf16x8 pack8(const f32x16& p, int o) { u32x4 w; w.x = pk2(p[o], p[o + 1]); w.y = pk2(p[o + 2], p[o + 3]); w.z = pk2(p[o + 4], p[o + 5]); w.w = pk2(p[o + 6], p[o + 7]); return __builtin_bit_cast(bf16x8, w); }

__device__ __forceinline__ void attn_unit(int b, int h, int qb, const bf16_t* __restrict__ Q, const bf16_t* __restrict__ Kb, const bf16_t* __restrict__ Vb, bf16_t* __restrict__ O, LAS unsigned char* lds, const int tid) {
    const int lane = tid & 63, wid = __builtin_amdgcn_readfirstlane(tid >> 6), r32 = lane & 31, hi = lane >> 5, late = wid >> 2;
    const size_t tok0 = (size_t)b * SEQ;
    const int qw0 = qb * 256 + wid * 32;
    const bf16_t* qp = Q + (tok0 + qw0) * (NH * DQK) + h * DQK + (unsigned)(r32 * (NH * DQK) + hi * 8);
    bf16x8 qf[12];
#pragma unroll
    for (int d0 = 0; d0 < 12; ++d0) qf[d0] = *(const GAS bf16x8*)(qp + d0 * 16);
    const bf16_t* kgb = Kb + (tok0 * NH + h) * DQK; const bf16_t* vgb = Vb + tok0 * (NH * DV) + h * DV;
    const unsigned kgo = (unsigned)((tid >> 3) * (NH * DQK) + (tid & 7) * 8), vgo = (unsigned)((tid >> 3) * (NH * DV) + (tid & 7) * 8);
    LAS unsigned char* klp = lds + (tid >> 3) * KSTR + (tid & 7) * 16;
    LAS unsigned char* vlp = lds + KT_BYTES + (tid >> 3) * VSTR + (tid & 7) * 16;
    const int kfo = r32 * KSTR + hi * 16;
    const int vfo = KT_BYTES + (4 * hi + ((lane & 15) >> 2)) * VSTR + (16 * ((lane >> 4) & 1) + 4 * (lane & 3)) * 2;
    f32x16 o[4];
#pragma unroll
    for (int i = 0; i < 4; ++i)
#pragma unroll
        for (int r = 0; r < 16; ++r) o[i][r] = 0.f;
    float m = -1e30f, l = 0.f;
    const int NT = 4 * (qb + 1);
    u32x4 kr[3], vr[2];
#pragma unroll
    for (int i = 0; i < 3; ++i) kr[i] = *(const GAS u32x4*)(kgb + (kgo + i * 64));
#pragma unroll
    for (int i = 0; i < 2; ++i) vr[i] = *(const GAS u32x4*)(vgb + (vgo + i * 64));
#pragma unroll
    for (int i = 0; i < 3; ++i) *(LAS u32x4*)(klp + i * 128) = kr[i];
#pragma unroll
    for (int i = 0; i < 2; ++i) *(LAS u32x4*)(vlp + i * 128) = vr[i];
    if (NT > 1) {
#pragma unroll
        for (int i = 0; i < 3; ++i) kr[i] = *(const GAS u32x4*)(kgb + (size_t)64 * (NH * DQK) + (kgo + i * 64));
#pragma unroll
        for (int i = 0; i < 2; ++i) vr[i] = *(const GAS u32x4*)(vgb + (size_t)64 * (NH * DV) + (vgo + i * 64)); }
    ABAR();
    if (late) ABAR();
    bf16x8 pf[4];
#pragma unroll
    for (int i = 0; i < 4; ++i) pf[i] = (bf16x8){0, 0, 0, 0, 0, 0, 0, 0};
    int sprev = 2 * STG, scur = 0, snext = STG;
#pragma unroll 1
    for (int t = 0; ; ++t) {
        const bool more = (t + 1 < NT);
        f32x16 s0, s1;
        if (t >= 1 && 64 * (t - 1) <= qw0 + 31) {
            const LAS unsigned char* vp = lds + sprev + vfo;
            s16x4 vA[8], vB[8];
#define LDV(dst, ks) do { _Pragma("unroll") for (int db = 0; db < 4; ++db) { dst[2 * db] = vtr(vp + (16 * (ks)) * VSTR + 64 * db); dst[2 * db + 1] = vtr(vp + (16 * (ks) + 8) * VSTR + 64 * db); } } while (0)
#define PVM(srcv, ks) do { _Pragma("unroll") for (int db = 0; db < 4; ++db) o[db] = MFMA32(__builtin_shufflevector(srcv[2 * db], srcv[2 * db + 1], 0, 1, 2, 3, 4, 5, 6, 7), pf[ks], o[db]); } while (0)
            LDV(vA, 0); __builtin_amdgcn_sched_barrier(0);
            LDV(vB, 1); __builtin_amdgcn_sched_barrier(0); PVM(vA, 0); __builtin_amdgcn_sched_barrier(0);
            LDV(vA, 2); __builtin_amdgcn_sched_barrier(0); PVM(vB, 1); __builtin_amdgcn_sched_barrier(0);
            LDV(vB, 3); __builtin_amdgcn_sched_barrier(0); PVM(vA, 2); __builtin_amdgcn_sched_barrier(0);
            PVM(vB, 3); __builtin_amdgcn_sched_barrier(0);
#undef LDV
#undef PVM
        }
        if (t < NT && 64 * t <= qw0 + 31) {
            const LAS unsigned char* kp = lds + scur + kfo;
#pragma unroll
            for (int r = 0; r < 16; ++r) { s0[r] = 0.f; s1[r] = 0.f; }
            bf16x8 kA[2], kB[2], kC[2];
#define LDK(dst, d) do { dst[0] = *(const LAS bf16x8*)(kp + (d) * 32); dst[1] = *(const LAS bf16x8*)(kp + 32 * KSTR + (d) * 32); } while (0)
#define SKM(srck, d) do { s0 = MFMA32(srck[0], qf[d], s0); s1 = MFMA32(srck[1], qf[d], s1); } while (0)
#define SB() __builtin_amdgcn_sched_barrier(0)
            LDK(kA, 0); LDK(kB, 1); SB();
            LDK(kC, 2); SB(); SKM(kA, 0); SB();
            LDK(kA, 3); SB(); SKM(kB, 1); SB();
            LDK(kB, 4); SB(); SKM(kC, 2); SB();
            LDK(kC, 5); SB(); SKM(kA, 3); SB();
            LDK(kA, 6); SB(); SKM(kB, 4); SB();
            LDK(kB, 7); SB(); SKM(kC, 5); SB();
            LDK(kC, 8); SB(); SKM(kA, 6); SB();
            LDK(kA, 9); SB(); SKM(kB, 7); SB();
            LDK(kB, 10); SB(); SKM(kC, 8); SB();
            LDK(kC, 11); SB(); SKM(kA, 9); SB();
            SKM(kB, 10); SB(); SKM(kC, 11); SB();
#undef LDK
#undef SKM
#undef SB
        }
        if (more) { LAS unsigned char* kl = klp + snext; LAS unsigned char* vl = vlp + snext;
#pragma unroll
            for (int i = 0; i < 3; ++i) *(LAS u32x4*)(kl + i * 128) = kr[i];
#pragma unroll
            for (int i = 0; i < 2; ++i) *(LAS u32x4*)(vl + i * 128) = vr[i]; }
        if (t == NT) break;
        ABAR();
        if (t + 2 < NT) { const bf16_t* kg = kgb + (size_t)(t + 2) * 64 * (NH * DQK); const bf16_t* vg = vgb + (size_t)(t + 2) * 64 * (NH * DV);
#pragma unroll
            for (int i = 0; i < 3; ++i) kr[i] = *(const GAS u32x4*)(kg + (kgo + i * 64));
#pragma unroll
            for (int i = 0; i < 2; ++i) vr[i] = *(const GAS u32x4*)(vg + (vgo + i * 64)); }
        if (64 * t <= qw0 + 31) {
            if (64 * t + 63 > qw0) { const int qpos = qw0 + r32, kb = 64 * t + 4 * hi;
#pragma unroll
                for (int r = 0; r < 16; ++r) { const int key = kb + (r & 3) + 8 * (r >> 2); if (key > qpos) s0[r] = -1e30f; if (key + 32 > qpos) s1[r] = -1e30f; } }
            float mxa = max3f(s0[0], s0[1], s1[0]), mxb = max3f(s0[2], s0[3], s1[1]); mxa = max3f(mxa, s1[2], s1[3]);
#pragma unroll
            for (int r = 4; r < 16; r += 4) { mxa = max3f(mxa, s0[r], s0[r + 1]); mxb = max3f(mxb, s0[r + 2], s0[r + 3]); mxa = max3f(mxa, s1[r], s1[r + 1]); mxb = max3f(mxb, s1[r + 2], s1[r + 3]); }
            float mx = max3f(mxa, mxb, mxb);
            mx = fmaxf(mx, shx(mx, 32, lane));
            const bool bump = mx > m + 8.f;
            if (__any(bump)) { const float mnew = bump ? mx : m, alpha = __builtin_amdgcn_exp2f(m - mnew); m = mnew; l *= alpha;
#pragma unroll
                for (int i = 0; i < 4; ++i)
#pragma unroll
                    for (int r = 0; r < 16; ++r) o[i][r] *= alpha; }
            float ls = 0.f;
#pragma unroll
            for (int r = 0; r < 16; ++r) { s0[r] = __builtin_amdgcn_exp2f(s0[r] - m); s1[r] = __builtin_amdgcn_exp2f(s1[r] - m); ls += s0[r] + s1[r]; }
            l += ls;
            pf[0] = pack8(s0, 0); pf[1] = pack8(s0, 8); pf[2] = pack8(s1, 0); pf[3] = pack8(s1, 8);
        }
        ABAR();
        { const int tmp = sprev; sprev = scur; scur = snext; snext = tmp; }
    }
    if (!late) ABAR();
    ABAR();
    const float lt = l + shx(l, 32, lane), inv = 1.0f / lt;
    int lane2 = lane; asm volatile("" : "+v"(lane2));
    const int hi2 = lane2 >> 5;
    bf16_t* op = O + (tok0 + qw0) * (NH * DV) + h * DV + (unsigned)((lane2 & 31) * (NH * DV) + 8 * hi2);
#pragma unroll
    for (int db = 0; db < 4; ++db)
#pragma unroll
        for (int j = 0; j < 2; ++j) {
            const unsigned g0x = pk2(o[db][8 * j] * inv, o[db][8 * j + 1] * inv), g0y = pk2(o[db][8 * j + 2] * inv, o[db][8 * j + 3] * inv);
            const unsigned g1x = pk2(o[db][8 * j + 4] * inv, o[db][8 * j + 5] * inv), g1y = pk2(o[db][8 * j + 6] * inv, o[db][8 * j + 7] * inv);
            const unsigned sx = hi2 ? g0x : g1x, sy = hi2 ? g0y : g1y;
            const auto px = __builtin_amdgcn_permlane32_swap(sx, sx, false, false); const auto py = __builtin_amdgcn_permlane32_swap(sy, sy, false, false);
            const unsigned rx = hi2 ? px[0] : px[1], ry = hi2 ? py[0] : py[1];
            u32x4 w; w.x = hi2 ? rx : g0x; w.y = hi2 ? ry : g0y; w.z = hi2 ? g1x : rx; w.w = hi2 ? g1y : ry;
            *(GAS u32x4*)(op + 32 * db + 16 * j) = w; }
}
}

typedef __attribute__((address_space(1))) unsigned gu32;
#define XB_TMO      128
#define XB_XCNT(j)  (256  + 64 * (j))
#define XB_XSUB(j)  (1280 + 64 * (j))
#define XB_XGEN(j)  (2304 + 64 * (j))
#define XB_TOP      3328
#define XB_TOPGEN   3392
#define XCD_BAR_WORDS 3456
#define XB_SPIN_CAP (1u << 18)

__device__ __forceinline__ unsigned xb_ld(unsigned* p)              { return __hip_atomic_load(p, __ATOMIC_RELAXED, __HIP_MEMORY_SCOPE_AGENT); }
__device__ __forceinline__ unsigned xb_add(unsigned* p, unsigned v) { return __hip_atomic_fetch_add(p, v, __ATOMIC_RELAXED, __HIP_MEMORY_SCOPE_AGENT); }
__device__ __forceinline__ unsigned xb_xcc_id() { return (unsigned)__builtin_amdgcn_s_getreg((3 << 11) | 20) & 0xFu; }
#define XB_SPIN(cond, bar) do { unsigned _sp = 0; while (cond) { __builtin_amdgcn_s_sleep(1); \
    if ((++_sp & 255u) == 0u) { if (xb_ld(&(bar)[XB_TMO])) break; if (_sp > XB_SPIN_CAP) { atomicAdd(&(bar)[XB_TMO], 1u); break; } } } } while (0)

struct XcdBarrier {
    unsigned* bar; unsigned x;
    volatile LAS unsigned* st;
};

__device__ __forceinline__ XcdBarrier xcd_barrier_post(unsigned* bar, volatile LAS unsigned* st) {
    XcdBarrier b; b.bar = bar; b.x = xb_xcc_id(); b.st = st;
    if (threadIdx.x == 0) (void)xb_add(&bar[XB_XCNT(b.x)], 1u);
    return b;
}
__device__ __forceinline__ void xcd_barrier_complete(unsigned* bar, unsigned x, unsigned& nloc, unsigned& nx) {
    const unsigned G = gridDim.x * gridDim.y * gridDim.z;
    unsigned sum, cnt, mine, sp = 0u;
    for (;;) {
        sum = 0u; cnt = 0u; mine = 0u;
#pragma unroll
        for (unsigned j = 0; j < 16; ++j) { const unsigned c = xb_ld(&bar[XB_XCNT(j)]); sum += c; cnt += (c > 0u) ? 1u : 0u; mine = (j == x) ? c : mine; }
        if (sum == G) break;
        __builtin_amdgcn_s_sleep(1);
        if ((++sp & 255u) == 0u) { if (xb_ld(&bar[XB_TMO])) break; if (sp > XB_SPIN_CAP) { atomicAdd(&bar[XB_TMO], 1u); break; } }
    }
    nloc = mine > 0u ? mine : 1u; nx = cnt > 0u ? cnt : 1u;
}

__device__ __forceinline__ void xcd_barrier(const XcdBarrier& b) {
    asm volatile("s_waitcnt vmcnt(0)" ::: "memory");
    __syncthreads();
    if (threadIdx.x == 0) {
        unsigned* bar = b.bar;
        __builtin_amdgcn_s_waitcnt(0);
        unsigned nloc = b.st[0], nx = b.st[1];
        if (nloc == 0u) { xcd_barrier_complete(bar, b.x, nloc, nx); b.st[0] = nloc; b.st[1] = nx; }
        const unsigned old = xb_add(&bar[XB_XSUB(b.x)], 1u);
        const unsigned gen = old / nloc;
        if (old + 1u == (gen + 1u) * nloc) {
            __builtin_amdgcn_fence(__ATOMIC_RELEASE, "agent");
            asm volatile("s_waitcnt vmcnt(0)" ::: "memory");
            const unsigned og = xb_add(&bar[XB_TOP], 1u);
            const unsigned tg = og / nx;
            if (og + 1u == (tg + 1u) * nx) xb_add(&bar[XB_TOPGEN], 1u);
            else XB_SPIN(xb_ld(&bar[XB_TOPGEN]) == tg, bar);
            __builtin_amdgcn_fence(__ATOMIC_ACQUIRE, "agent");
            xb_add(&bar[XB_XGEN(b.x)], 1u);
            asm volatile("s_waitcnt vmcnt(0)" ::: "memory");
        } else {
            XB_SPIN(xb_ld(&bar[XB_XGEN(b.x)]) == gen, bar);
            __builtin_amdgcn_fence(__ATOMIC_ACQUIRE, "agent");
            asm volatile("s_waitcnt vmcnt(0)" ::: "memory");
        }
    }
    __syncthreads();
}

__global__ void __launch_bounds__(NTHREADS) fwd_megakernel(Params P0_) {
    extern __shared__ __attribute__((aligned(16))) unsigned char lds_raw[];
    LAS unsigned char* lds = (LAS unsigned char*)lds_raw;
    cg::grid_group grid = cg::this_grid();
    const float QSCALE = 0.07216878364870322f * 1.4426950408889634f;
    volatile LAS unsigned* bst = (volatile LAS unsigned*)(lds + 138240);
    if (threadIdx.x < 4) bst[threadIdx.x] = 0u;
    __syncthreads();
    const XcdBarrier xbar = xcd_barrier_post((unsigned*)P0_.ws, bst);

#ifndef DUP_MASK
#define DUP_MASK 0u
#endif
    const int it_lo = 2 * P0_.ph_lo, it_hi = 2 * P0_.ph_hi;
#pragma unroll 1
    for (int it = it_lo; it < it_hi; ++it) {
        const int ph = it >> 1;
        if ((it & 1) && !((DUP_MASK >> ph) & 1u)) continue;
        int tid = threadIdx.x; asm volatile("" : "+v"(tid));
        int bid = blockIdx.x; asm volatile("" : "+s"(bid));
        int G = gridDim.x; asm volatile("" : "+s"(G));
        const CAS Params* pp_ = (const CAS Params*)__builtin_amdgcn_kernarg_segment_ptr(); asm volatile("" : "+s"(pp_)); const CAS Params& P = *pp_;
        unsigned char* ws = P.ws; asm volatile("" : "+s"(ws));
        const int lane = tid & 63, wave = __builtin_amdgcn_readfirstlane(tid >> 6);
        const int gw = bid * 8 + wave, NGW = G * 8;
        float* mod = (float*)(ws + WS_MOD); const float* cs = (const float*)(ws + WS_CS);
        bf16_t* hb = (bf16_t*)(ws + WS_H); bf16_t* yb = (bf16_t*)(ws + WS_Y); bf16_t* lat = (bf16_t*)(ws + WS_LAT);
        bf16_t* cq = (bf16_t*)(ws + WS_CQ); bf16_t* ckv = (bf16_t*)(ws + WS_CKV);
        bf16_t* qb_ = (bf16_t*)(ws + WS_Q); bf16_t* kb_ = (bf16_t*)(ws + WS_K); bf16_t* vb_ = (bf16_t*)(ws + WS_V); bf16_t* big = (bf16_t*)(ws + WS_BIG);
        int njobs = 0;
        if (ph == 2 || ph == 6 || ph == 8 || ph == 9 || ph == 11 || ph == 13 || ph == 15 || ph == 16) njobs = 1; else if (ph == 4) njobs = 2;
        if (njobs) {
#pragma unroll 1
            for (int jb = 0; jb < njobs; ++jb) {
                pg8::Gemm g; pg8::EpiGen E; E.O2 = nullptr; E.cs = cs; E.scale = 1.f;
                if (ph == 2)       { g = pg8::Gemm{hb, (const bf16_t*)(ws + W_IN), MT, LATP, DM};  E.mode = 1; E.O = lat; E.ldc = LATP; }
                else if (ph == 4 && jb == 0) { g = pg8::Gemm{cq, (const bf16_t*)(ws + W_UQ), MT, NH * DQK, QL}; E.mode = 3; E.O = qb_; E.ldc = NH * DQK; E.scale = QSCALE; }
                else if (ph == 4)  { g = pg8::Gemm{ckv, (const bf16_t*)(ws + W_UKV), MT, NH * 256, KVL}; E.mode = 4; E.O = kb_; E.O2 = vb_; E.ldc = 0; }
                else if (ph == 6)  { g = pg8::Gemm{hb, (const bf16_t*)(ws + W_O), MT, DM, DM}; E.mode = 1; E.O = yb; E.ldc = DM; }
                else if (ph == 8 || ph == 15)  { const int l = ph == 15; g = pg8::Gemm{hb, (const bf16_t*)(ws + W_UP) + (size_t)l * DM * DFF, MT, DFF, DM}; E.mode = 2; E.O = big; E.ldc = DFF; }
                else if (ph == 9 || ph == 16)  { const int l = ph == 16; g = pg8::Gemm{big, (const bf16_t*)(ws + W_DN) + (size_t)l * DM * DFF, MT, DM, DFF}; E.mode = 1; E.O = yb; E.ldc = DM; }
                else if (ph == 11) { g = pg8::Gemm{hb, (const bf16_t*)(ws + W_CIN), MT, 3 * DM, DM}; E.mode = 5; E.O = big; E.O2 = big + (size_t)MT * DM; E.ldc = DM; }
                else               { g = pg8::Gemm{hb, (const bf16_t*)(ws + W_COUT), MT, DM, DM}; E.mode = 1; E.O = yb; E.ldc = DM; }
                pg8::StaticOrder S; S.init(g.M, g.N, G, bid);
                int tidj = tid; asm volatile("" : "+v"(tidj));
                pg8::gemm_phase<pg8::EpiGen, pg8::StaticOrder, true, true>(lds, g, S, E, tidj);
                __syncthreads();
                if (ph == 2) { int tid3 = tid; asm volatile("" : "+v"(tid3)); deferred_convert(P, ws, lds, tid3 & 63, __builtin_amdgcn_readfirstlane(tid3 >> 6), G, bid); }
            }
        } else if (ph == 0) {
            p0_prologue(P, ws, lds, tid, lane, wave, G, bid);
        } else if (ph == 1) {
            row_prenorm(P.x, P.norm_g, mod, 0, 1, hb, lane, gw, NGW);
        } else if (ph == 3) {
            row_latent(lat, P.mla_g_q, P.mla_g_kv, cs, cq, ckv, kb_, lane, gw, NGW);
        } else if (ph == 5) {
            const int vcu = (G % 8 == 0) ? (bid % 8) * (G / 8) + bid / 8 : bid;
            if (G == 256) { const int bh = vcu >> 2, s = vcu & 3;
#pragma unroll 1
                for (int i = 0; i < 4; ++i) { const int qb = (i == 0) ? 15 - s : (i == 1) ? 8 + s : (i == 2) ? 7 - s : s; int tid2 = tid; asm volatile("" : "+v"(tid2)); att::attn_unit(bh >> 4, bh & 15, qb, qb_, kb_, vb_, hb, lds, tid2); } }
            else {
#pragma unroll 1
                for (int u = bid; u < NB * NH * 16; u += G) { int tid2 = tid; asm volatile("" : "+v"(tid2)); att::attn_unit((u & 63) >> 4, u & 15, 15 - (u >> 6), qb_, kb_, vb_, hb, lds, tid2); } }
        } else if (ph == 12) {
            row_conv(big + (size_t)MT * DM, big, P.conv_w, hb, lane, gw, NGW);
        } else if (ph == 7 || ph == 10 || ph == 14 || ph == 17) {
            const int layer = ph >= 14, second = (ph == 10 || ph == 17);
            const float* ng = P.norm_g + (size_t)layer * 4 * DM; const float* md = mod + (size_t)layer * 4 * NMOD;
            const float* gpost = ng + (second ? 3 : 1) * DM; const float* gate = md + (second ? 5 : 2) * DM;
            bf16_t* xb = (bf16_t*)(ws + WS_XB);
            const float* gpre; const float* sc; const float* sh; bf16_t* hout = hb;
            if (!second) { gpre = ng + 2 * DM; sc = md + 4 * DM; sh = md + 3 * DM; }
            else if (layer == 0) { gpre = P.norm_g + 4 * DM; sc = mod + (size_t)4 * NMOD + 1 * DM; sh = mod + (size_t)4 * NMOD; }
            else { gpre = gpost; sc = gate; sh = gate; hout = nullptr; }
            row_resid((ph == 7) ? P.x : nullptr, xb, yb, (ph == 17) ? P.out : nullptr, xb, hout, gpost, gate, gpre, sc, sh, lane, gw, NGW);
        }
#ifdef EXTRA_SYNCS
        if (ph == 3) { for (int e = 0; e < EXTRA_SYNCS; ++e) grid.sync(); }
#endif
        if (it + 1 < it_hi) { if (P.use_cg) grid.sync(); else xcd_barrier(xbar); }
    }
}

extern "C" void kernel_launch(void* const* d_in, const int* in_sizes, int n_in, void* d_out, int out_size, void* d_ws, size_t ws_size, hipStream_t stream) {
    static int grid = 0;
    if (grid == 0) {
        if (n_in != 17 || out_size != MT * DM || ws_size < WS_END) { fprintf(stderr, "kernel_launch: unexpected problem (n_in %d, out %d, ws %zu)\n", n_in, out_size, ws_size); grid = -1; return; }
        int dev = 0, cus = 0, per_cu = 0;
        hipGetDevice(&dev); hipDeviceGetAttribute(&cus, hipDeviceAttributeMultiprocessorCount, dev);
        if (hipFuncSetAttribute((const void*)fwd_megakernel, hipFuncAttributeMaxDynamicSharedMemorySize, LDS_BYTES) != hipSuccess) { fprintf(stderr, "kernel_launch: hipFuncSetAttribute failed\n"); grid = -1; return; }
        if (hipOccupancyMaxActiveBlocksPerMultiprocessor(&per_cu, (const void*)fwd_megakernel, NTHREADS, LDS_BYTES) != hipSuccess || per_cu < 1) { fprintf(stderr, "kernel_launch: occupancy query says %d\n", per_cu); per_cu = 1; }
        (void)hipGetLastError();
        grid = cus;
        fprintf(stderr, "kernel_launch: cus %d per_cu %d grid %d ws %zu\n", cus, per_cu, grid, ws_size);
    }
    if (grid < 0) return;
    Params p{};
    p.x = (const float*)d_in[0]; p.c = (const float*)d_in[1]; p.pos = (const int*)d_in[2]; p.w_mod = (const float*)d_in[3]; p.b_mod = (const float*)d_in[4]; p.norm_g = (const float*)d_in[5];
    p.mla_w_in = (const float*)d_in[6]; p.mla_g_q = (const float*)d_in[7]; p.mla_g_kv = (const float*)d_in[8]; p.mla_w_uq = (const float*)d_in[9]; p.mla_w_ukv = (const float*)d_in[10]; p.mla_w_o = (const float*)d_in[11];
    p.conv_w_in = (const float*)d_in[12]; p.conv_w = (const float*)d_in[13]; p.conv_w_out = (const float*)d_in[14]; p.mlp_w_up = (const float*)d_in[15]; p.mlp_w_down = (const float*)d_in[16];
    p.out = (float*)d_out; p.ws = (unsigned char*)d_ws; p.ph_lo = 0; p.ph_hi = 18; p.use_cg = 0; p.pad = 0;
    if (hipMemsetAsync(d_ws, 0, 16384, stream) != hipSuccess) { fprintf(stderr, "kernel_launch: memset failed\n"); return; }
    void* args[] = {&p};
    hipError_t e = hipLaunchCooperativeKernel((const void*)fwd_megakernel, dim3(grid), dim3(NTHREADS), args, LDS_BYTES, stream);
    if (e != hipSuccess) fprintf(stderr, "kernel_launch: cooperative launch failed: %s (grid %d)\n", hipGetErrorString(e), grid);
}
```

```cpp
#include <hip/hip_runtime.h>
#include <hip/hip_cooperative_groups.h>
#include <cstdio>
#include <cstdint>
namespace cg = cooperative_groups;
namespace pg8 {
#define PG8_LAS __attribute__((address_space(3)))
typedef unsigned short bf16_t;
typedef short bf16x8 __attribute__((ext_vector_type(8)));
typedef float f32x4 __attribute__((ext_vector_type(4)));
typedef unsigned u32x4 __attribute__((ext_vector_type(4)));
constexpr int BM = 256, BK = 64, HALF = 128, HTB = HALF * BK * 2  , STAGE_BYTES = 8 * HTB, NXCD = 8, WGM = 8;

__host__ __device__ __forceinline__ int lds_byte(int r, int c) { const int st = (r >> 4) * 2 + (c >> 5), rr = r & 15, cc = c & 31, ob = rr * 64 + cc * 2; return st * 1024 + (ob ^ (((ob >> 9) & 1) << 5)); }
__host__ __device__ __forceinline__ void stage_rc(int b, int& R, int& C) { const int st = b / 1024, sb = b % 1024, swz = sb ^ (((sb >> 9) & 1) << 5); R = (st >> 1) * 16 + swz / 64; C = (st & 1) * 32 + (swz % 64) / 2; }
__host__ __device__ __forceinline__ int perm32(int rho) { const int n = rho >> 4, i = rho & 15; return 8 * (i >> 2) + 4 * n + (i & 3); }

struct Unit { int pm, pn; };
struct Gemm { const bf16_t* A; const bf16_t* Bt; int M, N, K; };

struct StaticOrder {
    int nM, nN, nwg, G, c;
    __host__ __device__ void init(int M, int N, int G_, int c_) { nM = M / BM; nN = N / BM; nwg = nM * nN; G = G_; c = c_; }
    __host__ __device__ bool next(int i, Unit& u) const {
        const long L = (long)i * G + c; if (L >= nwg) return false;
        int wgid = (int)L; { const int q = nwg / NXCD, r = nwg % NXCD, xcd = wgid % NXCD, off = wgid / NXCD; wgid = (xcd < r ? xcd * (q + 1) : r * (q + 1) + (xcd - r) * q) + off; }
        const int nig = WGM * nN, gid = wgid / nig, fm = gid * WGM, gsz = (nM - fm) < WGM ? (nM - fm) : WGM;
        u.pm = fm + ((wgid % nig) % gsz); u.pn = (wgid % nig) / gsz; return true;
    }
    __device__ __forceinline__ void a_ready(const Unit&) const {}
    __device__ __forceinline__ void done(const Unit&) const {}
};


__device__ __forceinline__ unsigned cvt_pk_bf16(float lo, float hi) { unsigned r; asm volatile("v_cvt_pk_bf16_f32 %0, %1, %2" : "=v"(r) : "v"(lo), "v"(hi)); return r; }

#define PG8_GAS __attribute__((address_space(1)))
struct EpiGen {
    static constexpr bool PERM = true, AFTER_DRAIN = false;
    int mode;
    void* O; int ldc; void* O2; const float* cs; float scale;
    __device__ __forceinline__ void operator()(const f32x4 (&acc)[2][2][4][2], const Unit& u, int wr, int wc, int fr, int fq) const {
        int row0 = u.pm * BM + wr * 64 + fr;
        int colb = u.pn * BM + wc * 32 + 8 * fq;
        asm volatile("" : "+v"(row0), "+v"(colb));
        int mode = this->mode; asm volatile("" : "+s"(mode));
        if (mode == 0) {
            float* base = (float*)O;
#pragma unroll
            for (int ai = 0; ai < 2; ++ai)
#pragma unroll
                for (int m = 0; m < 4; ++m) { float* rowp = base + (size_t)(row0 + ai * HALF + m * 16) * ldc + colb;
#pragma unroll
                    for (int bj = 0; bj < 2; ++bj) { *(PG8_GAS f32x4*)(rowp + bj * HALF) = acc[ai][bj][m][0]; *(PG8_GAS f32x4*)(rowp + bj * HALF + 4) = acc[ai][bj][m][1]; } }
        } else if (mode == 5 && u.pn < 16) {
            bf16_t* base = (bf16_t*)O; const int zc = u.pn * HALF + (colb & 127);
#pragma unroll
            for (int ai = 0; ai < 2; ++ai)
#pragma unroll
                for (int m = 0; m < 4; ++m) { const f32x4 v0 = acc[ai][0][m][0] * acc[ai][1][m][0], v1 = acc[ai][0][m][1] * acc[ai][1][m][1];
                    u32x4 w; w.x = cvt_pk_bf16(v0[0], v0[1]); w.y = cvt_pk_bf16(v0[2], v0[3]); w.z = cvt_pk_bf16(v1[0], v1[1]); w.w = cvt_pk_bf16(v1[2], v1[3]);
                    *(PG8_GAS u32x4*)(base + (size_t)(row0 + ai * HALF + m * 16) * ldc + zc) = w; }
        } else if (mode == 1 || mode == 2 || mode == 5) {
            bf16_t* base = (mode == 5) ? (bf16_t*)O2 - 16 * BM : (bf16_t*)O; const bool sq = (mode == 2);
#pragma unroll
            for (int ai = 0; ai < 2; ++ai)
#pragma unroll
                for (int m = 0; m < 4; ++m) { bf16_t* rowp = base + (size_t)(row0 + ai * HALF + m * 16) * ldc + colb;
#pragma unroll
                    for (int bj = 0; bj < 2; ++bj) { f32x4 v0 = acc[ai][bj][m][0], v1 = acc[ai][bj][m][1];
                        if (sq) {
#pragma unroll
                            for (int e = 0; e < 4; ++e) { const float a = fmaxf(v0[e], 0.f), b = fmaxf(v1[e], 0.f); v0[e] = a * a; v1[e] = b * b; } }
                        u32x4 w; w.x = cvt_pk_bf16(v0[0], v0[1]); w.y = cvt_pk_bf16(v0[2], v0[3]); w.z = cvt_pk_bf16(v1[0], v1[1]); w.w = cvt_pk_bf16(v1[2], v1[3]);
                        *(PG8_GAS u32x4*)(rowp + bj * HALF) = w; } }
        } else if (mode == 3) {
            bf16_t* base = (bf16_t*)O;
#pragma unroll
            for (int bj = 0; bj < 2; ++bj) {
                const int col = colb + bj * HALF, d = col % 192; const bool rope = d >= 128; const int j0 = (d - 128) >> 1;
#pragma unroll
                for (int ai = 0; ai < 2; ++ai)
#pragma unroll
                    for (int m = 0; m < 4; ++m) { const int row = row0 + ai * HALF + m * 16;
                        f32x4 v0 = acc[ai][bj][m][0] * scale, v1 = acc[ai][bj][m][1] * scale;
                        if (rope) { const f32x4 c0 = *(const PG8_GAS f32x4*)(cs + (size_t)row * 64 + 2 * j0), c1 = *(const PG8_GAS f32x4*)(cs + (size_t)row * 64 + 2 * j0 + 4);
                            f32x4 t0, t1;
                            t0[0] = v0[0] * c0[0] - v0[1] * c0[1]; t0[1] = v0[1] * c0[0] + v0[0] * c0[1];
                            t0[2] = v0[2] * c0[2] - v0[3] * c0[3]; t0[3] = v0[3] * c0[2] + v0[2] * c0[3];
                            t1[0] = v1[0] * c1[0] - v1[1] * c1[1]; t1[1] = v1[1] * c1[0] + v1[0] * c1[1];
                            t1[2] = v1[2] * c1[2] - v1[3] * c1[3]; t1[3] = v1[3] * c1[2] + v1[2] * c1[3];
                            v0 = t0; v1 = t1; }
                        u32x4 w; w.x = cvt_pk_bf16(v0[0], v0[1]); w.y = cvt_pk_bf16(v0[2], v0[3]); w.z = cvt_pk_bf16(v1[0], v1[1]); w.w = cvt_pk_bf16(v1[2], v1[3]);
                        *(PG8_GAS u32x4*)(base + (size_t)row * ldc + col) = w; } }
        } else {
            bf16_t* kb = (bf16_t*)O; bf16_t* vb = (bf16_t*)O2; const int h = u.pn, dcol = colb & 127;
#pragma unroll
            for (int ai = 0; ai < 2; ++ai)
#pragma unroll
                for (int m = 0; m < 4; ++m) { const size_t row = (size_t)(row0 + ai * HALF + m * 16);
#pragma unroll
                    for (int bj = 0; bj < 2; ++bj) { const f32x4 v0 = acc[ai][bj][m][0], v1 = acc[ai][bj][m][1];
                        u32x4 w; w.x = cvt_pk_bf16(v0[0], v0[1]); w.y = cvt_pk_bf16(v0[2], v0[3]); w.z = cvt_pk_bf16(v1[0], v1[1]); w.w = cvt_pk_bf16(v1[2], v1[3]);
                        if (bj == 0) *(PG8_GAS u32x4*)(kb + (row * 16 + h) * 192 + dcol) = w; else *(PG8_GAS u32x4*)(vb + row * 2048 + h * 128 + dcol) = w; } }
        }
    }
};

template <class Epi, class Sched, bool ALIGN_EPI = false, bool SP2 = false>
__device__ __forceinline__ void gemm_phase(PG8_LAS unsigned char* lds, const Gemm g, const Sched& S, const Epi& E, const int tid) {
    const int wid = __builtin_amdgcn_readfirstlane(tid >> 6), lane = tid & 63, wr = wid >> 2, wc = wid & 3, fr = lane & 15, fq = lane >> 4;
    const int K = g.K, nt = K / BK;
    unsigned voffA[2], voffB[2];
#pragma unroll
    for (int i = 0; i < 2; ++i) { int R, C; stage_rc(tid * 16 + i * 8192, R, C); const int Rb = Epi::PERM ? ((R & ~31) + perm32(R & 31)) : R;
        voffA[i] = (unsigned)(R * K + C) * 2u; voffB[i] = (unsigned)(Rb * K + C) * 2u; }
    const size_t kstep = (size_t)(BK * 2);
    const size_t hstep = (size_t)HALF * K * 2;
    const size_t tstep = 2 * hstep;
    const unsigned ldsw = (unsigned)wid * 1024u;
    const int aoff = lds_byte(wr * 64 + fr, fq * 8), boff = lds_byte(wc * 32 + fr, fq * 8);
#define PG8_SA(b, h) (((b) * 2 + (h)) * HTB)
#define PG8_SB(b, h) ((4 + (b) * 2 + (h)) * HTB)
#define PG8_STAGE(bufoff, gbase, voff) do { _Pragma("unroll") for (int _i = 0; _i < 2; ++_i) \
        __builtin_amdgcn_global_load_lds((const unsigned*)((const char*)(gbase) + (voff)[_i]), (PG8_LAS unsigned*)(lds + (bufoff) + ldsw + _i * 8192), 16, 0, 0); } while (0)
#define PG8_LDA(dst, b, h) do { _Pragma("unroll") for (int m = 0; m < 4; ++m) _Pragma("unroll") for (int k = 0; k < 2; ++k) dst[m][k] = *(const PG8_LAS bf16x8*)(lds + PG8_SA(b, h) + aoff + m * 2048 + k * 1024); } while (0)
#define PG8_LDB(dst, b, h) do { _Pragma("unroll") for (int n = 0; n < 2; ++n) _Pragma("unroll") for (int k = 0; k < 2; ++k) dst[n][k] = *(const PG8_LAS bf16x8*)(lds + PG8_SB(b, h) + boff + n * 2048 + k * 1024); } while (0)
#define PG8_MMA(ai, bj, At, Bt) do { __builtin_amdgcn_s_setprio(1); _Pragma("unroll") for (int m = 0; m < 4; ++m) _Pragma("unroll") for (int n = 0; n < 2; ++n) _Pragma("unroll") for (int k = 0; k < 2; ++k) \
        acc[ai][bj][m][n] = __builtin_amdgcn_mfma_f32_16x16x32_bf16(Bt[n][k], At[m][k], acc[ai][bj][m][n], 0, 0, 0); __builtin_amdgcn_s_setprio(0); } while (0)
#define PG8_WAIT_V(n) asm volatile("s_waitcnt vmcnt(" #n ")" ::: "memory")
#define PG8_WAIT_L(n) asm volatile("s_waitcnt lgkmcnt(" #n ")" ::: "memory")
#define PG8_BAR __builtin_amdgcn_s_barrier()
#define PG8_SCHED __builtin_amdgcn_sched_barrier(0)
    Unit cur, nxt; int ui = 0;
    if (!S.next(0, cur)) return;
    f32x4 acc[2][2][4][2];
#pragma unroll
    for (int a = 0; a < 2; ++a)
#pragma unroll
        for (int b = 0; b < 2; ++b)
#pragma unroll
            for (int m = 0; m < 4; ++m)
#pragma unroll
                for (int n = 0; n < 2; ++n) acc[a][b][m][n] = (f32x4){0.f, 0.f, 0.f, 0.f};
    bf16x8 At[4][2], B0[2][2], B1[2][2];
    const char* cA = (const char*)g.A + (size_t)cur.pm * tstep; const char* cB = (const char*)g.Bt + (size_t)cur.pn * tstep;
    S.a_ready(cur);
    if constexpr (SP2) {
        PG8_STAGE(PG8_SB(0, 0), cB, voffB); PG8_STAGE(PG8_SB(0, 1), cB + hstep, voffB); PG8_STAGE(PG8_SA(0, 0), cA, voffA); PG8_STAGE(PG8_SA(0, 1), cA + hstep, voffA);
        if (wr == 1) PG8_BAR;
        PG8_WAIT_V(2); PG8_BAR;
        PG8_STAGE(PG8_SB(1, 0), cB + kstep, voffB); PG8_STAGE(PG8_SA(1, 0), cA + kstep, voffA); PG8_STAGE(PG8_SB(1, 1), cB + hstep + kstep, voffB);
        PG8_WAIT_V(6); PG8_BAR;
    } else {
        PG8_STAGE(PG8_SB(0, 0), cB, voffB); PG8_STAGE(PG8_SA(0, 0), cA, voffA); PG8_STAGE(PG8_SB(0, 1), cB + hstep, voffB); PG8_STAGE(PG8_SA(0, 1), cA + hstep, voffA);
        if (wr == 1) PG8_BAR;
        PG8_WAIT_V(4); PG8_BAR;
        PG8_STAGE(PG8_SB(1, 0), cB + kstep, voffB); PG8_STAGE(PG8_SA(1, 0), cA + kstep, voffA); PG8_STAGE(PG8_SB(1, 1), cB + hstep + kstep, voffB);
        PG8_WAIT_V(6); PG8_BAR;
    }
    for (;;) {
        const bool has_next = S.next(ui + 1, nxt);
        const char* nA = has_next ? (const char*)g.A + (size_t)nxt.pm * tstep : cA; const char* nB = has_next ? (const char*)g.Bt + (size_t)nxt.pn * tstep : cB;
        for (int t = 0; t < nt; t += 2) {
            const bool last = (t == nt - 2);
            const char* a1 = cA + (size_t)(t + 1) * kstep;
            const char* a2 = last ? nA : cA + (size_t)(t + 2) * kstep; const char* b2 = last ? nB : cB + (size_t)(t + 2) * kstep;
            const char* a3 = a2 + kstep; const char* b3 = b2 + kstep;
            if (last && has_next) S.a_ready(nxt);
            if constexpr (SP2) {
            PG8_LDB(B0, 0, 0); PG8_LDB(B1, 0, 1); PG8_SCHED; PG8_LDA(At, 0, 0); PG8_STAGE(PG8_SA(1, 1), a1 + hstep, voffA);
            PG8_WAIT_V(8); PG8_WAIT_L(0); PG8_BAR; PG8_MMA(0, 0, At, B0); PG8_MMA(0, 1, At, B1); PG8_BAR; PG8_SCHED;
            PG8_LDA(At, 0, 1); PG8_STAGE(PG8_SB(0, 0), b2, voffB); PG8_STAGE(PG8_SB(0, 1), b2 + hstep, voffB); PG8_STAGE(PG8_SA(0, 0), a2, voffA);
            PG8_WAIT_V(8); PG8_WAIT_L(0); PG8_BAR; PG8_MMA(1, 0, At, B0); PG8_MMA(1, 1, At, B1); PG8_BAR; PG8_SCHED;
            PG8_LDB(B0, 1, 0); PG8_LDB(B1, 1, 1); PG8_SCHED; PG8_LDA(At, 1, 0); PG8_STAGE(PG8_SA(0, 1), a2 + hstep, voffA);
            PG8_WAIT_V(8); PG8_WAIT_L(0); PG8_BAR; PG8_MMA(0, 0, At, B0); PG8_MMA(0, 1, At, B1); PG8_BAR; PG8_SCHED;
            PG8_LDA(At, 1, 1); PG8_STAGE(PG8_SB(1, 0), b3, voffB); PG8_STAGE(PG8_SB(1, 1), b3 + hstep, voffB); PG8_STAGE(PG8_SA(1, 0), a3, voffA);
            PG8_WAIT_V(8); PG8_WAIT_L(0); PG8_BAR; PG8_MMA(1, 0, At, B0); PG8_MMA(1, 1, At, B1); PG8_BAR; PG8_SCHED;
            } else {
            PG8_LDB(B0, 0, 0); PG8_SCHED; PG8_LDA(At, 0, 0); PG8_STAGE(PG8_SA(1, 1), a1 + hstep, voffA);
            PG8_WAIT_L(8); PG8_BAR; PG8_WAIT_L(0); PG8_MMA(0, 0, At, B0); PG8_BAR; PG8_SCHED;
            PG8_LDB(B1, 0, 1); PG8_STAGE(PG8_SB(0, 0), b2, voffB);
            PG8_BAR; PG8_WAIT_L(0); PG8_MMA(0, 1, At, B1); PG8_BAR;
            PG8_LDA(At, 0, 1); PG8_STAGE(PG8_SA(0, 0), a2, voffA);
            PG8_BAR; PG8_WAIT_L(0); PG8_MMA(1, 0, At, B0); PG8_BAR; PG8_SCHED;
            PG8_STAGE(PG8_SB(0, 1), b2 + hstep, voffB);
            PG8_WAIT_V(6); PG8_BAR; PG8_MMA(1, 1, At, B1); PG8_BAR;
            PG8_LDB(B0, 1, 0); PG8_SCHED; PG8_LDA(At, 1, 0); PG8_STAGE(PG8_SA(0, 1), a2 + hstep, voffA);
            PG8_WAIT_L(8); PG8_BAR; PG8_WAIT_L(0); PG8_MMA(0, 0, At, B0); PG8_BAR; PG8_SCHED;
            PG8_LDB(B1, 1, 1); PG8_STAGE(PG8_SB(1, 0), b3, voffB);
            PG8_BAR; PG8_WAIT_L(0); PG8_MMA(0, 1, At, B1); PG8_BAR;
            PG8_LDA(At, 1, 1); PG8_STAGE(PG8_SA(1, 0), a3, voffA);
            PG8_BAR; PG8_WAIT_L(0); PG8_MMA(1, 0, At, B0); PG8_BAR; PG8_SCHED;
            PG8_STAGE(PG8_SB(1, 1), b3 + hstep, voffB);
            PG8_WAIT_V(6); PG8_BAR; PG8_MMA(1, 1, At, B1); PG8_BAR;
            }
        }
        if constexpr (ALIGN_EPI) { if (wr == 0) PG8_BAR; }
        if constexpr (!Epi::AFTER_DRAIN) { E(acc, cur, wr, wc, fr, fq); S.done(cur); }
        if (!has_next) break;
#pragma unroll
        for (int a = 0; a < 2; ++a)
#pragma unroll
            for (int b = 0; b < 2; ++b)
#pragma unroll
                for (int m = 0; m < 4; ++m)
#pragma unroll
                    for (int n = 0; n < 2; ++n) acc[a][b][m][n] = (f32x4){0.f, 0.f, 0.f, 0.f};
        cur = nxt; cA = nA; cB = nB; ++ui;
        if constexpr (ALIGN_EPI) { if (wr == 1) PG8_BAR; }
    }
    PG8_WAIT_V(0);
    if constexpr (!ALIGN_EPI) { if (wr == 0) PG8_BAR; }
    PG8_BAR;
    if constexpr (Epi::AFTER_DRAIN) { E.fused(acc, cur, wr, wc, fr, fq, lds, wid, lane); S.done(cur); }
#undef PG8_SA
#undef PG8_SB
#undef PG8_STAGE
#undef PG8_LDA
#undef PG8_LDB
#undef PG8_MMA
#undef PG8_WAIT_V
#undef PG8_WAIT_L
#undef PG8_BAR
#undef PG8_SCHED
}
}

#define LAS __attribute__((address_space(3)))
typedef unsigned short bf16_t;
typedef short bf16x8 __attribute__((ext_vector_type(8)));
typedef short s16x4 __attribute__((ext_vector_type(4)));
typedef float f32x4 __attribute__((ext_vector_type(4)));
typedef float f32x16 __attribute__((ext_vector_type(16)));
typedef unsigned u32x4 __attribute__((ext_vector_type(4)));
typedef unsigned u32x2 __attribute__((ext_vector_type(2)));

constexpr int DM = 2048, NB = 4, SEQ = 4096, MT = NB * SEQ, NH = 16, DQK = 192, DV = 128, QL = 512, KVL = 512, LATP = 1280, LATN = 1088, DFF = 8192, NMOD = 6 * DM;
constexpr float EPS = 1e-6f;
constexpr size_t MiB = 1u << 20;
constexpr size_t WS_MOD = 1 * MiB, WS_CS = 2 * MiB;
constexpr size_t W_IN = 8 * MiB, W_UQ = 13 * MiB, W_UKV = 16 * MiB, W_O = 20 * MiB, W_CIN = 28 * MiB, W_COUT = 52 * MiB, W_UP = 60 * MiB, W_DN = 124 * MiB;
constexpr size_t WS_H = 192 * MiB, WS_Y = 256 * MiB, WS_LAT = 256 * MiB, WS_CQ = 336 * MiB, WS_CKV = 352 * MiB;
constexpr size_t WS_BIG = 384 * MiB, WS_Q = 384 * MiB, WS_K = 480 * MiB, WS_V = 576 * MiB, WS_XB = 640 * MiB, WS_END = 704 * MiB;
constexpr int LDS_BYTES = 139264;
constexpr int NTHREADS = 512;

__device__ __forceinline__ unsigned pk2(float lo, float hi) { typedef float f2 __attribute__((ext_vector_type(2))); typedef __bf16 b2 __attribute__((ext_vector_type(2))); f2 v = {lo, hi}; b2 b = __builtin_convertvector(v, b2); return __builtin_bit_cast(unsigned, b); }
__device__ __forceinline__ float bflo(unsigned w) { return __uint_as_float(w << 16); }
__device__ __forceinline__ float bfhi(unsigned w) { return __uint_as_float(w & 0xffff0000u); }
__device__ __forceinline__ float shx(float v, int mask, int lane) { return __int_as_float(__builtin_amdgcn_ds_bpermute((lane ^ mask) << 2, __float_as_int(v))); }
__device__ __forceinline__ float wave_sum(float v, int lane) {
#pragma unroll
    for (int o = 32; o >= 1; o >>= 1) v += shx(v, o, lane);
    return v;
}

#define CAS __attribute__((address_space(4)))
struct Params {
    const float* x; const float* c; const int* pos; const float* w_mod; const float* b_mod; const float* norm_g;
    const float* mla_w_in; const float* mla_g_q; const float* mla_g_kv; const float* mla_w_uq; const float* mla_w_ukv; const float* mla_w_o;
    const float* conv_w_in; const float* conv_w; const float* conv_w_out; const float* mlp_w_up; const float* mlp_w_down;
    float* out; unsigned char* ws; int ph_lo, ph_hi, use_cg, pad;
};

#define GASR __attribute__((address_space(1)))
__device__ __forceinline__ void transpose_item(const float* __restrict__ W, int K, int N, bf16_t* __restrict__ WT, int qperm  , LAS float* scr, int item, int lane) {
    const int nblk = N / 64, kb = item / nblk, nb = item % nblk, k0 = 64 * kb, n0 = 64 * nb;
    f32x4 v[16];
    const float* src = W + (size_t)(k0 + (lane >> 4)) * N + n0 + 4 * (lane & 15);
#pragma unroll
    for (int i = 0; i < 16; ++i) v[i] = __builtin_nontemporal_load((const f32x4*)(src + (size_t)(4 * i) * N));
#pragma unroll
    for (int i = 0; i < 16; ++i) { LAS float* d = scr + (4 * i + (lane >> 4)) * 65 + 4 * (lane & 15); d[0] = v[i][0]; d[1] = v[i][1]; d[2] = v[i][2]; d[3] = v[i][3]; }
    asm volatile("s_waitcnt lgkmcnt(0)" ::: "memory");
    const int c = lane & 7;
#pragma unroll
    for (int j = 0; j < 8; ++j) { const int n = (lane >> 3) + 8 * j; const LAS float* s = scr + (8 * c) * 65 + n;
        u32x4 o; o.x = pk2(s[0 * 65], s[1 * 65]); o.y = pk2(s[2 * 65], s[3 * 65]); o.z = pk2(s[4 * 65], s[5 * 65]); o.w = pk2(s[6 * 65], s[7 * 65]);
        int nr = n0 + n;
        if (qperm == 1) { const int hh = nr / 192, d = nr % 192; if (d >= 128) { const int j2 = d - 128; nr = hh * 192 + 128 + ((j2 < 32) ? 2 * j2 : 2 * (j2 - 32) + 1); } }
        else if (qperm == 2) { if (nr < DM) nr += 2 * DM; else { const int u_ = nr >= 2 * DM, ch = nr - (u_ ? 2 * DM : DM); nr = (ch >> 7) * 256 + u_ * 128 + (ch & 127); } }
        *(GASR u32x4*)(WT + (size_t)nr * K + k0 + 8 * c) = o; }
    asm volatile("s_waitcnt lgkmcnt(0)" ::: "memory");
}

__device__ __forceinline__ float inv_freq_f(int j) {
    const int a = j >> 3, b = j & 7;
    const float fb = b == 0 ? 1.0f : b == 1 ? 0.7498942093324559f : b == 2 ? 0.5623413251903491f : b == 3 ? 0.4216965034285822f : b == 4 ? 0.31622776601683794f : b == 5 ? 0.23713737056616552f : b == 6 ? 0.1778279410038923f : 0.1333521432163324f;
    const float fa = a == 0 ? 1.0f : a == 1 ? 0.1f : a == 2 ? 0.01f : 0.001f;
    return fa * fb;
}
__device__ __forceinline__ void sincos_acc(float angf, float& c, float& s) {
    const double ang = (double)angf;
    const double n = __builtin_rint(ang * 0.6366197723675814);
    double rd = __builtin_fma(-n, 1.5707963267948966, ang); rd = __builtin_fma(-n, 6.123233995736766e-17, rd);
    const float r = (float)rd, z = r * r;
    const float sr = r + r * z * (-1.6666654611e-1f + z * (8.3321608736e-3f + z * -1.9515295891e-4f));
    const float cr = 1.0f - 0.5f * z + z * z * (4.166664568298827e-2f + z * (-1.388731625493765e-3f + z * 2.443315711809948e-5f));
    const int q = ((int)n) & 3;
    s = (q == 0) ? sr : (q == 1) ? cr : (q == 2) ? -sr : -cr;
    c = (q == 0) ? cr : (q == 1) ? -sr : (q == 2) ? -cr : sr;
}

__device__ __forceinline__ void p0_prologue(const CAS Params& P, unsigned char* ws, LAS unsigned char* lds, int tid, int lane, int wave, int G, int bid) {
    float* mod = (float*)(ws + WS_MOD); float* cs = (float*)(ws + WS_CS);
    for (int i = bid * NTHREADS + tid; i < MT * 32; i += G * NTHREADS) { const int t = i >> 5, j = i & 31;
        const float ang = (float)P.pos[t] * inv_freq_f(j); float c_, s_; sincos_acc(ang, c_, s_); cs[2 * i] = c_; cs[2 * i + 1] = s_; }
    LAS float* condL = (LAS float*)lds; LAS float* red = (LAS float*)(lds + 32768);
    for (int i = tid; i < NB * DM; i += NTHREADS) { const float v = P.c[i]; condL[i] = v / (1.f + __expf(-v)); }
    __syncthreads();
    for (int unit = bid; unit < 2 * (NMOD / 32); unit += G) {
        const int layer = unit / (NMOD / 32), cb = unit % (NMOD / 32);
        const float* W = P.w_mod + (size_t)layer * DM * NMOD + cb * 32 + 4 * (lane & 7);
        const int kph = wave * 8 + (lane >> 3);
        f32x4 acc[4];
#pragma unroll
        for (int b = 0; b < 4; ++b) acc[b] = (f32x4){0.f, 0.f, 0.f, 0.f};
#pragma unroll 16
        for (int kk = 0; kk < 32; ++kk) { const int k = kph + 64 * kk; const f32x4 w = __builtin_nontemporal_load((const f32x4*)(W + (size_t)k * NMOD));
#pragma unroll
            for (int b = 0; b < 4; ++b) acc[b] += w * condL[b * DM + k]; }
#pragma unroll
        for (int b = 0; b < 4; ++b) *(LAS f32x4*)(red + ((kph * 4 + b) * 32 + 4 * (lane & 7))) = acc[b];
        __syncthreads();
        if (tid < 128) { const int b = tid >> 5, cc = tid & 31; float s = 0.f;
#pragma unroll 8
            for (int kp = 0; kp < 64; ++kp) s += red[(kp * 4 + b) * 32 + cc];
            mod[(size_t)(layer * 4 + b) * NMOD + cb * 32 + cc] = s + P.b_mod[layer * NMOD + cb * 32 + cc]; }
        __syncthreads();
    }
    LAS float* scr = (LAS float*)(lds + wave * 16640);
    const int gw = bid * 8 + wave, NGW = G * 8;
    constexpr int I_IN = (DM / 64) * (LATN / 64), I_UQ = (QL / 64) * (NH * DQK / 64), I_UKV = (KVL / 64) * (NH * 256 / 64), I_O = (DM / 64) * (DM / 64),
                  I_CIN = (DM / 64) * (3 * DM / 64), I_UP = (DM / 64) * (DFF / 64), I_DN = (DFF / 64) * (DM / 64);
    constexpr int NITEMS = I_IN + I_UQ + I_UKV + I_O + I_CIN + I_O + 2 * I_UP + I_DN;
    for (int it = gw; it < NITEMS; it += NGW) {
        int r = it;
        if (r < I_IN) { transpose_item(P.mla_w_in, DM, LATN, (bf16_t*)(ws + W_IN), 0, scr, r, lane); continue; } r -= I_IN;
        if (r < I_UQ) { transpose_item(P.mla_w_uq, QL, NH * DQK, (bf16_t*)(ws + W_UQ), 1, scr, r, lane); continue; } r -= I_UQ;
        if (r < I_UKV) { transpose_item(P.mla_w_ukv, KVL, NH * 256, (bf16_t*)(ws + W_UKV), 0, scr, r, lane); continue; } r -= I_UKV;
        if (r < I_O) { transpose_item(P.mla_w_o, DM, DM, (bf16_t*)(ws + W_O), 0, scr, r, lane); continue; } r -= I_O;
        if (r < I_CIN) { transpose_item(P.conv_w_in, DM, 3 * DM, (bf16_t*)(ws + W_CIN), 2, scr, r, lane); continue; } r -= I_CIN;
        if (r < I_O) { transpose_item(P.conv_w_out, DM, DM, (bf16_t*)(ws + W_COUT), 0, scr, r, lane); continue; } r -= I_O;
        if (r < 2 * I_UP) { const int l = r / I_UP; transpose_item(P.mlp_w_up + (size_t)l * DM * DFF, DM, DFF, (bf16_t*)(ws + W_UP) + (size_t)l * DM * DFF, 0, scr, r % I_UP, lane); continue; } r -= 2 * I_UP;
        { transpose_item(P.mlp_w_down, DFF, DM, (bf16_t*)(ws + W_DN), 0, scr, r, lane); }
    }
}

__device__ __forceinline__ void deferred_convert(const CAS Params& P, unsigned char* ws, LAS unsigned char* lds, int lane, int wave, int G, int bid) {
    constexpr int I_DN = (DFF / 64) * (DM / 64);
    const int nwg = (MT / 256) * (LATP / 256), rounds = (nwg + G - 1) / G, nlight = rounds * G - nwg, first_light = G - nlight;
    int gwl, ngwl;
    if (nlight > 0) { if (bid < first_light) return; gwl = (bid - first_light) * 8 + wave; ngwl = nlight * 8; } else { gwl = bid * 8 + wave; ngwl = G * 8; }
    LAS float* scr = (LAS float*)(lds + wave * 16640);
    for (int it = gwl; it < I_DN; it += ngwl) transpose_item(P.mlp_w_down + (size_t)DM * DFF, DFF, DM, (bf16_t*)(ws + W_DN) + (size_t)DM * DFF, 0, scr, it, lane);
}

__device__ __forceinline__ void row_prenorm(const float* __restrict__ x, const float* __restrict__ g, const float* __restrict__ modl  , int shi, int sci, bf16_t* __restrict__ h, int lane, int gw, int NGW) {
    for (int m0 = gw * 8; m0 < MT; m0 += NGW * 8) {
        const int b = m0 / SEQ; const float* md = modl + (size_t)b * NMOD;
        f32x4 A[8], B[8];
#pragma unroll
        for (int j = 0; j < 8; ++j) { const int c = 4 * lane + 256 * j; const f32x4 gg = *(const GASR f32x4*)(g + c), sc = *(const GASR f32x4*)(md + sci * DM + c); A[j] = gg * (sc + 1.f); B[j] = *(const GASR f32x4*)(md + shi * DM + c); }
#pragma unroll 1
        for (int r = 0; r < 8; ++r) { const size_t row = (size_t)(m0 + r);
            f32x4 v[8]; float ss = 0.f;
#pragma unroll
            for (int j = 0; j < 8; ++j) { v[j] = *(const GASR f32x4*)(x + row * DM + 4 * lane + 256 * j); ss += (v[j][0] * v[j][0] + v[j][1] * v[j][1]) + (v[j][2] * v[j][2] + v[j][3] * v[j][3]); }
            const float rstd = 1.0f / sqrtf(wave_sum(ss, lane) * (1.0f / DM) + EPS);
#pragma unroll
            for (int j = 0; j < 8; ++j) { const f32x4 o = v[j] * rstd * A[j] + B[j]; u32x2 w; w.x = pk2(o[0], o[1]); w.y = pk2(o[2], o[3]); *(GASR u32x2*)(h + row * DM + 4 * lane + 256 * j) = w; }
        }
    }
}
__device__ __forceinline__ void row_resid(const float* __restrict__ xin_f, const bf16_t* xin_b, const bf16_t* __restrict__ y, float* __restrict__ xout_f, bf16_t* xout_b, bf16_t* __restrict__ h,
                                          const float* __restrict__ gpost, const float* __restrict__ gate  , const float* __restrict__ gpre, const float* __restrict__ sc, const float* __restrict__ sh,
                                          int lane, int gw, int NGW) {
    for (int m0 = gw * 8; m0 < MT; m0 += NGW * 8) {
        const int b = m0 / SEQ;
        f32x4 Gv[8];
#pragma unroll
        for (int j = 0; j < 8; ++j) { const int c = 4 * lane + 256 * j; Gv[j] = *(const GASR f32x4*)(gpost + c) * *(const GASR f32x4*)(gate + (size_t)b * NMOD + c); }
#pragma unroll 1
        for (int r = 0; r < 8; ++r) { const size_t row = (size_t)(m0 + r);
            f32x4 v[8], xv[8]; float ss = 0.f;
#pragma unroll
            for (int j = 0; j < 8; ++j) { const u32x2 yw = *(const GASR u32x2*)(y + row * DM + 4 * lane + 256 * j); v[j] = (f32x4){bflo(yw.x), bfhi(yw.x), bflo(yw.y), bfhi(yw.y)};
                ss += (v[j][0] * v[j][0] + v[j][1] * v[j][1]) + (v[j][2] * v[j][2] + v[j][3] * v[j][3]); }
            if (xin_f) {
#pragma unroll
                for (int j = 0; j < 8; ++j) xv[j] = *(const GASR f32x4*)(xin_f + row * DM + 4 * lane + 256 * j);
            } else {
#pragma unroll
                for (int j = 0; j < 8; ++j) { const u32x2 xw = *(const GASR u32x2*)(xin_b + row * DM + 4 * lane + 256 * j); xv[j] = (f32x4){bflo(xw.x), bfhi(xw.x), bflo(xw.y), bfhi(xw.y)}; }
            }
            const float rstd = 1.0f / sqrtf(wave_sum(ss, lane) * (1.0f / DM) + EPS);
            float s2 = 0.f;
#pragma unroll
            for (int j = 0; j < 8; ++j) { xv[j] = xv[j] + v[j] * rstd * Gv[j]; s2 += (xv[j][0] * xv[j][0] + xv[j][1] * xv[j][1]) + (xv[j][2] * xv[j][2] + xv[j][3] * xv[j][3]); }
            if (xout_f) {
#pragma unroll
                for (int j = 0; j < 8; ++j) *(GASR f32x4*)(xout_f + row * DM + 4 * lane + 256 * j) = xv[j];
            } else {
#pragma unroll
                for (int j = 0; j < 8; ++j) { u32x2 w; w.x = pk2(xv[j][0], xv[j][1]); w.y = pk2(xv[j][2], xv[j][3]); *(GASR u32x2*)(xout_b + row * DM + 4 * lane + 256 * j) = w; }
            }
            if (h) { const float rs2 = 1.0f / sqrtf(wave_sum(s2, lane) * (1.0f / DM) + EPS);
#pragma unroll
                for (int j = 0; j < 8; ++j) { const int c = 4 * lane + 256 * j;
                    const f32x4 A = *(const GASR f32x4*)(gpre + c) * (*(const GASR f32x4*)(sc + (size_t)b * NMOD + c) + 1.f), B = *(const GASR f32x4*)(sh + (size_t)b * NMOD + c);
                    const f32x4 o = xv[j] * rs2 * A + B; u32x2 w; w.x = pk2(o[0], o[1]); w.y = pk2(o[2], o[3]); *(GASR u32x2*)(h + row * DM + c) = w; } }
        }
    }
}
__device__ __forceinline__ void row_latent(const bf16_t* __restrict__ lat, const float* __restrict__ gq, const float* __restrict__ gkv, const float* __restrict__ cs,
                                           bf16_t* __restrict__ cq, bf16_t* __restrict__ ckv, bf16_t* __restrict__ Kb, int lane, int gw, int NGW) {
    for (int row = gw; row < MT; row += NGW) { const bf16_t* lr = lat + (size_t)row * LATP;
#pragma unroll
        for (int part = 0; part < 2; ++part) { const bf16_t* src = lr + part * 512; const float* gg = part ? gkv : gq; bf16_t* dst = (part ? ckv : cq) + (size_t)row * 512;
            const u32x2 r0 = *(const GASR u32x2*)(src + 4 * lane), r1 = *(const GASR u32x2*)(src + 256 + 4 * lane);
            const f32x4 a0 = {bflo(r0.x), bfhi(r0.x), bflo(r0.y), bfhi(r0.y)}, a1 = {bflo(r1.x), bfhi(r1.x), bflo(r1.y), bfhi(r1.y)};
            const float ss = (a0[0] * a0[0] + a0[1] * a0[1]) + (a0[2] * a0[2] + a0[3] * a0[3]) + (a1[0] * a1[0] + a1[1] * a1[1]) + (a1[2] * a1[2] + a1[3] * a1[3]);
            const float rstd = 1.0f / sqrtf(wave_sum(ss, lane) * (1.0f / 512.f) + EPS);
            const f32x4 o0 = a0 * rstd * *(const GASR f32x4*)(gg + 4 * lane), o1 = a1 * rstd * *(const GASR f32x4*)(gg + 256 + 4 * lane);
            u32x2 w0, w1; w0.x = pk2(o0[0], o0[1]); w0.y = pk2(o0[2], o0[3]); w1.x = pk2(o1[0], o1[1]); w1.y = pk2(o1[2], o1[3]);
            *(GASR u32x2*)(dst + 4 * lane) = w0; *(GASR u32x2*)(dst + 256 + 4 * lane) = w1; }
        if (lane < 32) { const float x1 = __uint_as_float((unsigned)lr[1024 + lane] << 16), x2 = __uint_as_float((unsigned)lr[1056 + lane] << 16), c_ = cs[(size_t)row * 64 + 2 * lane], s_ = cs[(size_t)row * 64 + 2 * lane + 1];
            const unsigned w = pk2(x1 * c_ - x2 * s_, x2 * c_ + x1 * s_);
#pragma unroll
            for (int hh = 0; hh < NH; ++hh) *(GASR unsigned*)(Kb + ((size_t)row * NH + hh) * DQK + 128 + 2 * lane) = w; }
    }
}
__device__ __forceinline__ void row_conv(const bf16_t* __restrict__ bb, const bf16_t* __restrict__ zz, const float* __restrict__ cw, bf16_t* __restrict__ gz, int lane, int gw, int NGW) {
    for (int m0 = gw * 8; m0 < MT; m0 += NGW * 8) {
        const int s0 = m0 % SEQ;
#pragma unroll 1
        for (int j = 0; j < 4; ++j) { const int c0 = 8 * lane + 512 * j;
            float w0[8], w1[8], w2[8], zm2[8], zm1[8];
            { const f32x4 a = *(const GASR f32x4*)(cw + c0), b = *(const GASR f32x4*)(cw + c0 + 4), c = *(const GASR f32x4*)(cw + DM + c0), d = *(const GASR f32x4*)(cw + DM + c0 + 4), e = *(const GASR f32x4*)(cw + 2 * DM + c0), f = *(const GASR f32x4*)(cw + 2 * DM + c0 + 4);
#pragma unroll
              for (int i = 0; i < 4; ++i) { w0[i] = a[i]; w0[4 + i] = b[i]; w1[i] = c[i]; w1[4 + i] = d[i]; w2[i] = e[i]; w2[4 + i] = f[i]; } }
#pragma unroll
            for (int i = 0; i < 8; ++i) { zm2[i] = 0.f; zm1[i] = 0.f; }
            if (s0 >= 2) { const u32x4 za = *(const GASR u32x4*)(zz + (size_t)(m0 - 2) * DM + c0), zb = *(const GASR u32x4*)(zz + (size_t)(m0 - 1) * DM + c0);
#pragma unroll
                for (int i = 0; i < 4; ++i) { zm2[2 * i] = bflo(za[i]); zm2[2 * i + 1] = bfhi(za[i]); zm1[2 * i] = bflo(zb[i]); zm1[2 * i + 1] = bfhi(zb[i]); } }
#pragma unroll
            for (int r = 0; r < 8; ++r) { const size_t off = (size_t)(m0 + r) * DM + c0; const u32x4 bv = *(const GASR u32x4*)(bb + off), zv = *(const GASR u32x4*)(zz + off);
                float z[8], o[8];
#pragma unroll
                for (int i = 0; i < 4; ++i) { z[2 * i] = bflo(zv[i]); z[2 * i + 1] = bfhi(zv[i]); }
#pragma unroll
                for (int i = 0; i < 4; ++i) { o[2 * i] = bflo(bv[i]) * (w0[2 * i] * zm2[2 * i] + w1[2 * i] * zm1[2 * i] + w2[2 * i] * z[2 * i]); o[2 * i + 1] = bfhi(bv[i]) * (w0[2 * i + 1] * zm2[2 * i + 1] + w1[2 * i + 1] * zm1[2 * i + 1] + w2[2 * i + 1] * z[2 * i + 1]); }
                u32x4 w; w.x = pk2(o[0], o[1]); w.y = pk2(o[2], o[3]); w.z = pk2(o[4], o[5]); w.w = pk2(o[6], o[7]);
                *(GASR u32x4*)(gz + off) = w;
#pragma unroll
                for (int i = 0; i < 8; ++i) { zm2[i] = zm1[i]; zm1[i] = z[i]; } }
        }
    }
}

namespace att {
constexpr int KSTR = 400, VSTR = 320, KT_BYTES = 64 * KSTR, VT_BYTES = 64 * VSTR, STG = KT_BYTES + VT_BYTES, NSTG = 3;
static_assert(NSTG * STG <= 138240, "attention LDS");
#define GAS __attribute__((address_space(1)))
#define ABAR() do { asm volatile("s_waitcnt lgkmcnt(0)" ::: "memory"); __builtin_amdgcn_s_barrier(); asm volatile("" ::: "memory"); } while (0)
#define MFMA32(a, b, c) __builtin_amdgcn_mfma_f32_32x32x16_bf16((a), (b), (c), 0, 0, 0)
__device__ __forceinline__ float max3f(float a, float b, float c) { float r; asm("v_max3_f32 %0, %1, %2, %3" : "=v"(r) : "v"(a), "v"(b), "v"(c)); return r; }
__device__ __forceinline__ s16x4 vtr(const LAS unsigned char* p) { typedef short v4i16_t __attribute__((ext_vector_type(4))); return __builtin_bit_cast(s16x4, __builtin_amdgcn_ds_read_tr16_b64_v4i16((LAS v4i16_t*)p)); }
__device__ __forceinline__ bf16x8 pack8(const f32x16& p, int o) { u32x4 w; w.x = pk2(p[o], p[o + 1]); w.y = pk2(p[o + 2], p[o + 3]); w.z = pk2(p[o + 4], p[o + 5]); w.w = pk2(p[o + 6], p[o + 7]); return __builtin_bit_cast(bf16x8, w); }

__device__ __forceinline__ void attn_unit(int b, int h, int qb, const bf16_t* __restrict__ Q, const bf16_t* __restrict__ Kb, const bf16_t* __restrict__ Vb, bf16_t* __restrict__ O, LAS unsigned char* lds, const int tid) {
    const int lane = tid & 63, wid = __builtin_amdgcn_readfirstlane(tid >> 6), r32 = lane & 31, hi = lane >> 5, late = wid >> 2;
    const size_t tok0 = (size_t)b * SEQ;
    const int qw0 = qb * 256 + wid * 32;
    const bf16_t* qp = Q + (tok0 + qw0) * (NH * DQK) + h * DQK + (unsigned)(r32 * (NH * DQK) + hi * 8);
    bf16x8 qf[12];
#pragma unroll
    for (int d0 = 0; d0 < 12; ++d0) qf[d0] = *(const GAS bf16x8*)(qp + d0 * 16);
    const bf16_t* kgb = Kb + (tok0 * NH + h) * DQK; const bf16_t* vgb = Vb + tok0 * (NH * DV) + h * DV;
    const unsigned kgo = (unsigned)((tid >> 3) * (NH * DQK) + (tid & 7) * 8), vgo = (unsigned)((tid >> 3) * (NH * DV) + (tid & 7) * 8);
    LAS unsigned char* klp = lds + (tid >> 3) * KSTR + (tid & 7) * 16;
    LAS unsigned char* vlp = lds + KT_BYTES + (tid >> 3) * VSTR + (tid & 7) * 16;
    const int kfo = r32 * KSTR + hi * 16;
    const int vfo = KT_BYTES + (4 * hi + ((lane & 15) >> 2)) * VSTR + (16 * ((lane >> 4) & 1) + 4 * (lane & 3)) * 2;
    f32x16 o[4];
#pragma unroll
    for (int i = 0; i < 4; ++i)
#pragma unroll
        for (int r = 0; r < 16; ++r) o[i][r] = 0.f;
    float m = -1e30f, l = 0.f;
    const int NT = 4 * (qb + 1);
    u32x4 kr[3], vr[2];
#pragma unroll
    for (int i = 0; i < 3; ++i) kr[i] = *(const GAS u32x4*)(kgb + (kgo + i * 64));
#pragma unroll
    for (int i = 0; i < 2; ++i) vr[i] = *(const GAS u32x4*)(vgb + (vgo + i * 64));
#pragma unroll
    for (int i = 0; i < 3; ++i) *(LAS u32x4*)(klp + i * 128) = kr[i];
#pragma unroll
    for (int i = 0; i < 2; ++i) *(LAS u32x4*)(vlp + i * 128) = vr[i];
    if (NT > 1) {
#pragma unroll
        for (int i = 0; i < 3; ++i) kr[i] = *(const GAS u32x4*)(kgb + (size_t)64 * (NH * DQK) + (kgo + i * 64));
#pragma unroll
        for (int i = 0; i < 2; ++i) vr[i] = *(const GAS u32x4*)(vgb + (size_t)64 * (NH * DV) + (vgo + i * 64)); }
    ABAR();
    if (late) { __builtin_amdgcn_s_setprio(1); ABAR(); }
    bf16x8 pf[4];
#pragma unroll
    for (int i = 0; i < 4; ++i) pf[i] = (bf16x8){0, 0, 0, 0, 0, 0, 0, 0};
    int sprev = 2 * STG, scur = 0, snext = STG;
#pragma unroll 1
    for (int t = 0; ; ++t) {
        const bool more = (t + 1 < NT);
        f32x16 s0, s1;
        if (t >= 1 && 64 * (t - 1) <= qw0 + 31) {
            const LAS unsigned char* vp = lds + sprev + vfo;
            s16x4 vA[8], vB[8];
#define LDV(dst, ks) do { _Pragma("unroll") for (int db = 0; db < 4; ++db) { dst[2 * db] = vtr(vp + (16 * (ks)) * VSTR + 64 * db); dst[2 * db + 1] = vtr(vp + (16 * (ks) + 8) * VSTR + 64 * db); } } while (0)
#define PVM(srcv, ks) do { _Pragma("unroll") for (int db = 0; db < 4; ++db) o[db] = MFMA32(__builtin_shufflevector(srcv[2 * db], srcv[2 * db + 1], 0, 1, 2, 3, 4, 5, 6, 7), pf[ks], o[db]); } while (0)
            LDV(vA, 0); __builtin_amdgcn_sched_barrier(0);
            LDV(vB, 1); __builtin_amdgcn_sched_barrier(0); PVM(vA, 0); __builtin_amdgcn_sched_barrier(0);
            LDV(vA, 2); __builtin_amdgcn_sched_barrier(0); PVM(vB, 1); __builtin_amdgcn_sched_barrier(0);
            LDV(vB, 3); __builtin_amdgcn_sched_barrier(0); PVM(vA, 2); __builtin_amdgcn_sched_barrier(0);
            PVM(vB, 3); __builtin_amdgcn_sched_barrier(0);
#undef LDV
#undef PVM
        }
        if (t < NT && 64 * t <= qw0 + 31) {
            const LAS unsigned char* kp = lds + scur + kfo;
#pragma unroll
            for (int r = 0; r < 16; ++r) { s0[r] = 0.f; s1[r] = 0.f; }
            bf16x8 kA[2], kB[2], kC[2];
#define LDK(dst, d) do { dst[0] = *(const LAS bf16x8*)(kp + (d) * 32); dst[1] = *(const LAS bf16x8*)(kp + 32 * KSTR + (d) * 32); } while (0)
#define SKM(srck, d) do { s0 = MFMA32(srck[0], qf[d], s0); s1 = MFMA32(srck[1], qf[d], s1); } while (0)
#define SB() __builtin_amdgcn_sched_barrier(0)
            LDK(kA, 0); LDK(kB, 1); SB();
            LDK(kC, 2); SB(); SKM(kA, 0); SB();
            LDK(kA, 3); SB(); SKM(kB, 1); SB();
            LDK(kB, 4); SB(); SKM(kC, 2); SB();
            LDK(kC, 5); SB(); SKM(kA, 3); SB();
            LDK(kA, 6); SB(); SKM(kB, 4); SB();
            LDK(kB, 7); SB(); SKM(kC, 5); SB();
            LDK(kC, 8); SB(); SKM(kA, 6); SB();
            LDK(kA, 9); SB(); SKM(kB, 7); SB();
            LDK(kB, 10); SB(); SKM(kC, 8); SB();
            LDK(kC, 11); SB(); SKM(kA, 9); SB();
            SKM(kB, 10); SB(); SKM(kC, 11); SB();
#undef LDK
#undef SKM
#undef SB
        }
        if (more) { LAS unsigned char* kl = klp + snext; LAS unsigned char* vl = vlp + snext;
#pragma unroll
            for (int i = 0; i < 3; ++i) *(LAS u32x4*)(kl + i * 128) = kr[i];
#pragma unroll
            for (int i = 0; i < 2; ++i) *(LAS u32x4*)(vl + i * 128) = vr[i]; }
        if (t == NT) break;
        ABAR();
        if (t + 2 < NT) { const bf16_t* kg = kgb + (size_t)(t + 2) * 64 * (NH * DQK); const bf16_t* vg = vgb + (size_t)(t + 2) * 64 * (NH * DV);
#pragma unroll
            for (int i = 0; i < 3; ++i) kr[i] = *(const GAS u32x4*)(kg + (kgo + i * 64));
#pragma unroll
            for (int i = 0; i < 2; ++i) vr[i] = *(const GAS u32x4*)(vg + (vgo + i * 64)); }
        if (64 * t <= qw0 + 31) {
            if (64 * t + 63 > qw0) { const int qpos = qw0 + r32, kb = 64 * t + 4 * hi;
#pragma unroll
                for (int r = 0; r < 16; ++r) { const int key = kb + (r & 3) + 8 * (r >> 2); if (key > qpos) s0[r] = -1e30f; if (key + 32 > qpos) s1[r] = -1e30f; } }
            float mxa = max3f(s0[0], s0[1], s1[0]), mxb = max3f(s0[2], s0[3], s1[1]); mxa = max3f(mxa, s1[2], s1[3]);
#pragma unroll
            for (int r = 4; r < 16; r += 4) { mxa = max3f(mxa, s0[r], s0[r + 1]); mxb = max3f(mxb, s0[r + 2], s0[r + 3]); mxa = max3f(mxa, s1[r], s1[r + 1]); mxb = max3f(mxb, s1[r + 2], s1[r + 3]); }
            float mx = max3f(mxa, mxb, mxb);
            { auto rr_ = __builtin_amdgcn_permlane32_swap(__float_as_uint(mx), __float_as_uint(mx), false, false); mx = fmaxf(__uint_as_float(rr_[0]), __uint_as_float(rr_[1])); }
            const bool bump = mx > m + 8.f;
            if (__any(bump)) { const float mnew = bump ? mx : m, alpha = __builtin_amdgcn_exp2f(m - mnew); m = mnew; l *= alpha;
#pragma unroll
                for (int i = 0; i < 4; ++i)
#pragma unroll
                    for (int r = 0; r < 16; ++r) o[i][r] *= alpha; }
#pragma unroll
            for (int r = 0; r < 16; ++r) { s0[r] -= m; s1[r] -= m; }
            asm volatile("" : "+v"(s0), "+v"(s1));
#pragma unroll
            for (int r = 0; r < 16; ++r) { s0[r] = __builtin_amdgcn_exp2f(s0[r]); s1[r] = __builtin_amdgcn_exp2f(s1[r]); }
            asm volatile("" : "+v"(s0), "+v"(s1));
            { float a0 = s0[0] + s1[0], a1 = s0[1] + s1[1], a2 = s0[2] + s1[2], a3 = s0[3] + s1[3];
#pragma unroll
              for (int r = 4; r < 16; r += 4) { a0 += s0[r] + s1[r]; a1 += s0[r + 1] + s1[r + 1]; a2 += s0[r + 2] + s1[r + 2]; a3 += s0[r + 3] + s1[r + 3]; }
              l += (a0 + a1) + (a2 + a3); }
            pf[0] = pack8(s0, 0); pf[1] = pack8(s0, 8); pf[2] = pack8(s1, 0); pf[3] = pack8(s1, 8);
        }
        ABAR();
        { const int tmp = sprev; sprev = scur; scur = snext; snext = tmp; }
    }
    if (!late) ABAR();
    ABAR();
    __builtin_amdgcn_s_setprio(0);
    const float lt = l + shx(l, 32, lane), inv = 1.0f / lt;
    int lane2 = lane; asm volatile("" : "+v"(lane2));
    const int hi2 = lane2 >> 5;
    bf16_t* op = O + (tok0 + qw0) * (NH * DV) + h * DV + (unsigned)((lane2 & 31) * (NH * DV) + 8 * hi2);
#pragma unroll
    for (int db = 0; db < 4; ++db)
#pragma unroll
        for (int j = 0; j < 2; ++j) {
            const unsigned g0x = pk2(o[db][8 * j] * inv, o[db][8 * j + 1] * inv), g0y = pk2(o[db][8 * j + 2] * inv, o[db][8 * j + 3] * inv);
            const unsigned g1x = pk2(o[db][8 * j + 4] * inv, o[db][8 * j + 5] * inv), g1y = pk2(o[db][8 * j + 6] * inv, o[db][8 * j + 7] * inv);
            const unsigned sx = hi2 ? g0x : g1x, sy = hi2 ? g0y : g1y;
            const auto px = __builtin_amdgcn_permlane32_swap(sx, sx, false, false); const auto py = __builtin_amdgcn_permlane32_swap(sy, sy, false, false);
            const unsigned rx = hi2 ? px[0] : px[1], ry = hi2 ? py[0] : py[1];
            u32x4 w; w.x = hi2 ? rx : g0x; w.y = hi2 ? ry : g0y; w.z = hi2 ? g1x : rx; w.w = hi2 ? g1y : ry;
            *(GAS u32x4*)(op + 32 * db + 16 * j) = w; }
}
}

typedef __attribute__((address_space(1))) unsigned gu32;
#define XB_TMO      128
#define XB_XCNT(j)  (256  + 64 * (j))
#define XB_XSUB(j)  (1280 + 64 * (j))
#define XB_XGEN(j)  (2304 + 64 * (j))
#define XB_TOP      3328
#define XB_TOPGEN   3392
#define XCD_BAR_WORDS 3456
#define XB_SPIN_CAP (1u << 18)

__device__ __forceinline__ unsigned xb_ld(unsigned* p)              { return __hip_atomic_load(p, __ATOMIC_RELAXED, __HIP_MEMORY_SCOPE_AGENT); }
__device__ __forceinline__ unsigned xb_add(unsigned* p, unsigned v) { return __hip_atomic_fetch_add(p, v, __ATOMIC_RELAXED, __HIP_MEMORY_SCOPE_AGENT); }
__device__ __forceinline__ unsigned xb_xcc_id() { return (unsigned)__builtin_amdgcn_s_getreg((3 << 11) | 20) & 0xFu; }
#define XB_SPIN(cond, bar) do { unsigned _sp = 0; while (cond) { __builtin_amdgcn_s_sleep(1); \
    if ((++_sp & 255u) == 0u) { if (xb_ld(&(bar)[XB_TMO])) break; if (_sp > XB_SPIN_CAP) { atomicAdd(&(bar)[XB_TMO], 1u); break; } } } } while (0)

struct XcdBarrier {
    unsigned* bar; unsigned x;
    volatile LAS unsigned* st;
};

__device__ __forceinline__ XcdBarrier xcd_barrier_post(unsigned* bar, volatile LAS unsigned* st) {
    XcdBarrier b; b.bar = bar; b.x = xb_xcc_id(); b.st = st;
    if (threadIdx.x == 0) (void)xb_add(&bar[XB_XCNT(b.x)], 1u);
    return b;
}
__device__ __forceinline__ void xcd_barrier_complete(unsigned* bar, unsigned x, unsigned& nloc, unsigned& nx) {
    const unsigned G = gridDim.x * gridDim.y * gridDim.z;
    unsigned sum, cnt, mine, sp = 0u;
    for (;;) {
        sum = 0u; cnt = 0u; mine = 0u;
#pragma unroll
        for (unsigned j = 0; j < 16; ++j) { const unsigned c = xb_ld(&bar[XB_XCNT(j)]); sum += c; cnt += (c > 0u) ? 1u : 0u; mine = (j == x) ? c : mine; }
        if (sum == G) break;
        __builtin_amdgcn_s_sleep(1);
        if ((++sp & 255u) == 0u) { if (xb_ld(&bar[XB_TMO])) break; if (sp > XB_SPIN_CAP) { atomicAdd(&bar[XB_TMO], 1u); break; } }
    }
    nloc = mine > 0u ? mine : 1u; nx = cnt > 0u ? cnt : 1u;
}

__device__ __forceinline__ void xcd_barrier(const XcdBarrier& b) {
    asm volatile("s_waitcnt vmcnt(0)" ::: "memory");
    __syncthreads();
    if (threadIdx.x == 0) {
        unsigned* bar = b.bar;
        __builtin_amdgcn_s_waitcnt(0);
        unsigned nloc = b.st[0], nx = b.st[1];
        if (nloc == 0u) { xcd_barrier_complete(bar, b.x, nloc, nx); b.st[0] = nloc; b.st[1] = nx; }
        const unsigned old = xb_add(&bar[XB_XSUB(b.x)], 1u);
        const unsigned gen = old / nloc;
        if (old + 1u == (gen + 1u) * nloc) {
            __builtin_amdgcn_fence(__ATOMIC_RELEASE, "agent");
            asm volatile("s_waitcnt vmcnt(0)" ::: "memory");
            const unsigned og = xb_add(&bar[XB_TOP], 1u);
            const unsigned tg = og / nx;
            if (og + 1u == (tg + 1u) * nx) xb_add(&bar[XB_TOPGEN], 1u);
            else XB_SPIN(xb_ld(&bar[XB_TOPGEN]) == tg, bar);
            __builtin_amdgcn_fence(__ATOMIC_ACQUIRE, "agent");
            xb_add(&bar[XB_XGEN(b.x)], 1u);
            asm volatile("s_waitcnt vmcnt(0)" ::: "memory");
        } else {
            XB_SPIN(xb_ld(&bar[XB_XGEN(b.x)]) == gen, bar);
            __builtin_amdgcn_fence(__ATOMIC_ACQUIRE, "agent");
            asm volatile("s_waitcnt vmcnt(0)" ::: "memory");
        }
    }
    __syncthreads();
}

__global__ void __launch_bounds__(NTHREADS) fwd_megakernel(Params P0_) {
    extern __shared__ __attribute__((aligned(16))) unsigned char lds_raw[];
    LAS unsigned char* lds = (LAS unsigned char*)lds_raw;
    cg::grid_group grid = cg::this_grid();
    const float QSCALE = 0.07216878364870322f * 1.4426950408889634f;
    volatile LAS unsigned* bst = (volatile LAS unsigned*)(lds + 138240);
    if (threadIdx.x < 4) bst[threadIdx.x] = 0u;
    __syncthreads();
    const XcdBarrier xbar = xcd_barrier_post((unsigned*)P0_.ws, bst);

#ifndef DUP_MASK
#define DUP_MASK 0u
#endif
    const int it_lo = 2 * P0_.ph_lo, it_hi = 2 * P0_.ph_hi;
#pragma unroll 1
    for (int it = it_lo; it < it_hi; ++it) {
        const int ph = it >> 1;
        if ((it & 1) && !((DUP_MASK >> ph) & 1u)) continue;
        int tid = threadIdx.x; asm volatile("" : "+v"(tid));
        int bid = blockIdx.x; asm volatile("" : "+s"(bid));
        int G = gridDim.x; asm volatile("" : "+s"(G));
        const CAS Params* pp_ = (const CAS Params*)__builtin_amdgcn_kernarg_segment_ptr(); asm volatile("" : "+s"(pp_)); const CAS Params& P = *pp_;
        unsigned char* ws = P.ws; asm volatile("" : "+s"(ws));
        const int lane = tid & 63, wave = __builtin_amdgcn_readfirstlane(tid >> 6);
        const int gw = bid * 8 + wave, NGW = G * 8;
        float* mod = (float*)(ws + WS_MOD); const float* cs = (const float*)(ws + WS_CS);
        bf16_t* hb = (bf16_t*)(ws + WS_H); bf16_t* yb = (bf16_t*)(ws + WS_Y); bf16_t* lat = (bf16_t*)(ws + WS_LAT);
        bf16_t* cq = (bf16_t*)(ws + WS_CQ); bf16_t* ckv = (bf16_t*)(ws + WS_CKV);
        bf16_t* qb_ = (bf16_t*)(ws + WS_Q); bf16_t* kb_ = (bf16_t*)(ws + WS_K); bf16_t* vb_ = (bf16_t*)(ws + WS_V); bf16_t* big = (bf16_t*)(ws + WS_BIG);
        int njobs = 0;
        if (ph == 2 || ph == 6 || ph == 8 || ph == 9 || ph == 11 || ph == 13 || ph == 15 || ph == 16) njobs = 1; else if (ph == 4) njobs = 2;
        if (njobs) {
#pragma unroll 1
            for (int jb = 0; jb < njobs; ++jb) {
                pg8::Gemm g; pg8::EpiGen E; E.O2 = nullptr; E.cs = cs; E.scale = 1.f;
                if (ph == 2)       { g = pg8::Gemm{hb, (const bf16_t*)(ws + W_IN), MT, LATP, DM};  E.mode = 1; E.O = lat; E.ldc = LATP; }
                else if (ph == 4 && jb == 0) { g = pg8::Gemm{cq, (const bf16_t*)(ws + W_UQ), MT, NH * DQK, QL}; E.mode = 3; E.O = qb_; E.ldc = NH * DQK; E.scale = QSCALE; }
                else if (ph == 4)  { g = pg8::Gemm{ckv, (const bf16_t*)(ws + W_UKV), MT, NH * 256, KVL}; E.mode = 4; E.O = kb_; E.O2 = vb_; E.ldc = 0; }
                else if (ph == 6)  { g = pg8::Gemm{hb, (const bf16_t*)(ws + W_O), MT, DM, DM}; E.mode = 1; E.O = yb; E.ldc = DM; }
                else if (ph == 8 || ph == 15)  { const int l = ph == 15; g = pg8::Gemm{hb, (const bf16_t*)(ws + W_UP) + (size_t)l * DM * DFF, MT, DFF, DM}; E.mode = 2; E.O = big; E.ldc = DFF; }
                else if (ph == 9 || ph == 16)  { const int l = ph == 16; g = pg8::Gemm{big, (const bf16_t*)(ws + W_DN) + (size_t)l * DM * DFF, MT, DM, DFF}; E.mode = 1; E.O = yb; E.ldc = DM; }
                else if (ph == 11) { g = pg8::Gemm{hb, (const bf16_t*)(ws + W_CIN), MT, 3 * DM, DM}; E.mode = 5; E.O = big; E.O2 = big + (size_t)MT * DM; E.ldc = DM; }
                else               { g = pg8::Gemm{hb, (const bf16_t*)(ws + W_COUT), MT, DM, DM}; E.mode = 1; E.O = yb; E.ldc = DM; }
                pg8::StaticOrder S; S.init(g.M, g.N, G, bid);
                int tidj = tid; asm volatile("" : "+v"(tidj));
                pg8::gemm_phase<pg8::EpiGen, pg8::StaticOrder, true, true>(lds, g, S, E, tidj);
                __syncthreads();
                if (ph == 2) { int tid3 = tid; asm volatile("" : "+v"(tid3)); deferred_convert(P, ws, lds, tid3 & 63, __builtin_amdgcn_readfirstlane(tid3 >> 6), G, bid); }
            }
        } else if (ph == 0) {
            p0_prologue(P, ws, lds, tid, lane, wave, G, bid);
        } else if (ph == 1) {
            row_prenorm(P.x, P.norm_g, mod, 0, 1, hb, lane, gw, NGW);
        } else if (ph == 3) {
            row_latent(lat, P.mla_g_q, P.mla_g_kv, cs, cq, ckv, kb_, lane, gw, NGW);
        } else if (ph == 5) {
            const int vcu = (G % 8 == 0) ? (bid % 8) * (G / 8) + bid / 8 : bid;
            if (G == 256) { const int bh = vcu >> 2, s = vcu & 3;
#pragma unroll 1
                for (int i = 0; i < 4; ++i) { const int qb = (i == 0) ? 15 - s : (i == 1) ? 8 + s : (i == 2) ? 7 - s : s; int tid2 = tid; asm volatile("" : "+v"(tid2)); att::attn_unit(bh >> 4, bh & 15, qb, qb_, kb_, vb_, hb, lds, tid2); } }
            else {
#pragma unroll 1
                for (int u = bid; u < NB * NH * 16; u += G) { int tid2 = tid; asm volatile("" : "+v"(tid2)); att::attn_unit((u & 63) >> 4, u & 15, 15 - (u >> 6), qb_, kb_, vb_, hb, lds, tid2); } }
        } else if (ph == 12) {
            row_conv(big + (size_t)MT * DM, big, P.conv_w, hb, lane, gw, NGW);
        } else if (ph == 7 || ph == 10 || ph == 14 || ph == 17) {
            const int layer = ph >= 14, second = (ph == 10 || ph == 17);
            const float* ng = P.norm_g + (size_t)layer * 4 * DM; const float* md = mod + (size_t)layer * 4 * NMOD;
            const float* gpost = ng + (second ? 3 : 1) * DM; const float* gate = md + (second ? 5 : 2) * DM;
            bf16_t* xb = (bf16_t*)(ws + WS_XB);
            const float* gpre; const float* sc; const float* sh; bf16_t* hout = hb;
            if (!second) { gpre = ng + 2 * DM; sc = md + 4 * DM; sh = md + 3 * DM; }
            else if (layer == 0) { gpre = P.norm_g + 4 * DM; sc = mod + (size_t)4 * NMOD + 1 * DM; sh = mod + (size_t)4 * NMOD; }
            else { gpre = gpost; sc = gate; sh = gate; hout = nullptr; }
            row_resid((ph == 7) ? P.x : nullptr, xb, yb, (ph == 17) ? P.out : nullptr, xb, hout, gpost, gate, gpre, sc, sh, lane, gw, NGW);
        }
#ifdef EXTRA_SYNCS
        if (ph == 3) { for (int e = 0; e < EXTRA_SYNCS; ++e) grid.sync(); }
#endif
        if (it + 1 < it_hi) { if (P.use_cg) grid.sync(); else xcd_barrier(xbar); }
    }
}

extern "C" void kernel_launch(void* const* d_in, const int* in_sizes, int n_in, void* d_out, int out_size, void* d_ws, size_t ws_size, hipStream_t stream) {
    static int grid = 0;
    if (grid == 0) {
        if (n_in != 17 || out_size != MT * DM || ws_size < WS_END) { fprintf(stderr, "kernel_launch: unexpected problem (n_in %d, out %d, ws %zu)\n", n_in, out_size, ws_size); grid = -1; return; }
        int dev = 0, cus = 0, per_cu = 0;
        hipGetDevice(&dev); hipDeviceGetAttribute(&cus, hipDeviceAttributeMultiprocessorCount, dev);
        if (hipFuncSetAttribute((const void*)fwd_megakernel, hipFuncAttributeMaxDynamicSharedMemorySize, LDS_BYTES) != hipSuccess) { fprintf(stderr, "kernel_launch: hipFuncSetAttribute failed\n"); grid = -1; return; }
        if (hipOccupancyMaxActiveBlocksPerMultiprocessor(&per_cu, (const void*)fwd_megakernel, NTHREADS, LDS_BYTES) != hipSuccess || per_cu < 1) { fprintf(stderr, "kernel_launch: occupancy query says %d\n", per_cu); per_cu = 1; }
        (void)hipGetLastError();
        grid = cus;
        fprintf(stderr, "kernel_launch: cus %d per_cu %d grid %d ws %zu\n", cus, per_cu, grid, ws_size);
    }
    if (grid < 0) return;
    Params p{};
    p.x = (const float*)d_in[0]; p.c = (const float*)d_in[1]; p.pos = (const int*)d_in[2]; p.w_mod = (const float*)d_in[3]; p.b_mod = (const float*)d_in[4]; p.norm_g = (const float*)d_in[5];
    p.mla_w_in = (const float*)d_in[6]; p.mla_g_q = (const float*)d_in[7]; p.mla_g_kv = (const float*)d_in[8]; p.mla_w_uq = (const float*)d_in[9]; p.mla_w_ukv = (const float*)d_in[10]; p.mla_w_o = (const float*)d_in[11];
    p.conv_w_in = (const float*)d_in[12]; p.conv_w = (const float*)d_in[13]; p.conv_w_out = (const float*)d_in[14]; p.mlp_w_up = (const float*)d_in[15]; p.mlp_w_down = (const float*)d_in[16];
    p.out = (float*)d_out; p.ws = (unsigned char*)d_ws; p.ph_lo = 0; p.ph_hi = 18; p.use_cg = 0; p.pad = 0;
    if (hipMemsetAsync(d_ws, 0, 16384, stream) != hipSuccess) { fprintf(stderr, "kernel_launch: memset failed\n"); return; }
    void* args[] = {&p};
    hipError_t e = hipLaunchCooperativeKernel((const void*)fwd_megakernel, dim3(grid), dim3(NTHREADS), args, LDS_BYTES, stream);
    if (e != hipSuccess) fprintf(stderr, "kernel_launch: cooperative launch failed: %s (grid %d)\n", hipGetErrorString(e), grid);
}
```

```cpp
#include <hip/hip_runtime.h>
#include <hip/hip_cooperative_groups.h>
#include <cstdio>
#include <cstdint>
namespace cg = cooperative_groups;
namespace pg8 {
#define PG8_LAS __attribute__((address_space(3)))
typedef unsigned short bf16_t;
typedef short bf16x8 __attribute__((ext_vector_type(8)));
typedef float f32x4 __attribute__((ext_vector_type(4)));
typedef unsigned u32x4 __attribute__((ext_vector_type(4)));
constexpr int BM = 256, BK = 64, HALF = 128, HTB = HALF * BK * 2  , STAGE_BYTES = 8 * HTB, NXCD = 8, WGM = 8;

__host__ __device__ __forceinline__ int lds_byte(int r, int c) { const int st = (r >> 4) * 2 + (c >> 5), rr = r & 15, cc = c & 31, ob = rr * 64 + cc * 2; return st * 1024 + (ob ^ (((ob >> 9) & 1) << 5)); }
__host__ __device__ __forceinline__ void stage_rc(int b, int& R, int& C) { const int st = b / 1024, sb = b % 1024, swz = sb ^ (((sb >> 9) & 1) << 5); R = (st >> 1) * 16 + swz / 64; C = (st & 1) * 32 + (swz % 64) / 2; }
__host__ __device__ __forceinline__ int perm32(int rho) { const int n = rho >> 4, i = rho & 15; return 8 * (i >> 2) + 4 * n + (i & 3); }

struct Unit { int pm, pn; };
struct Gemm { const bf16_t* A; const bf16_t* Bt; int M, N, K; };

struct StaticOrder {
    int nM, nN, nwg, G, c;
    __host__ __device__ void init(int M, int N, int G_, int c_) { nM = M / BM; nN = N / BM; nwg = nM * nN; G = G_; c = c_; }
    __host__ __device__ bool next(int i, Unit& u) const {
        const long L = (long)i * G + c; if (L >= nwg) return false;
        int wgid = (int)L; { const int q = nwg / NXCD, r = nwg % NXCD, xcd = wgid % NXCD, off = wgid / NXCD; wgid = (xcd < r ? xcd * (q + 1) : r * (q + 1) + (xcd - r) * q) + off; }
        const int nig = WGM * nN, gid = wgid / nig, fm = gid * WGM, gsz = (nM - fm) < WGM ? (nM - fm) : WGM;
        u.pm = fm + ((wgid % nig) % gsz); u.pn = (wgid % nig) / gsz; return true;
    }
    __device__ __forceinline__ void a_ready(const Unit&) const {}
    __device__ __forceinline__ void done(const Unit&) const {}
};


__device__ __forceinline__ unsigned cvt_pk_bf16(float lo, float hi) { typedef float f2_ __attribute__((ext_vector_type(2))); typedef __bf16 b2_ __attribute__((ext_vector_type(2))); f2_ v = {lo, hi}; b2_ b = __builtin_convertvector(v, b2_); return __builtin_bit_cast(unsigned, b); }

#define PG8_GAS __attribute__((address_space(1)))
struct EpiGen {
    static constexpr bool PERM = true, AFTER_DRAIN = false;
    int mode;
    void* O; int ldc; void* O2; const float* cs; float scale;
    __device__ __forceinline__ void operator()(const f32x4 (&acc)[2][2][4][2], const Unit& u, int wr, int wc, int fr, int fq) const {
        int row0 = u.pm * BM + wr * 64 + fr;
        int colb = u.pn * BM + wc * 32 + 8 * fq;
        asm volatile("" : "+v"(row0), "+v"(colb));
        int mode = this->mode; asm volatile("" : "+s"(mode));
        if (mode == 0) {
            float* base = (float*)O;
#pragma unroll
            for (int ai = 0; ai < 2; ++ai)
#pragma unroll
                for (int m = 0; m < 4; ++m) { float* rowp = base + (size_t)(row0 + ai * HALF + m * 16) * ldc + colb;
#pragma unroll
                    for (int bj = 0; bj < 2; ++bj) { *(PG8_GAS f32x4*)(rowp + bj * HALF) = acc[ai][bj][m][0]; *(PG8_GAS f32x4*)(rowp + bj * HALF + 4) = acc[ai][bj][m][1]; } }
        } else if (mode == 5 && u.pn < 16) {
            bf16_t* base = (bf16_t*)O; const int zc = u.pn * HALF + (colb & 127);
#pragma unroll
            for (int ai = 0; ai < 2; ++ai)
#pragma unroll
                for (int m = 0; m < 4; ++m) { const f32x4 v0 = acc[ai][0][m][0] * acc[ai][1][m][0], v1 = acc[ai][0][m][1] * acc[ai][1][m][1];
                    u32x4 w; w.x = cvt_pk_bf16(v0[0], v0[1]); w.y = cvt_pk_bf16(v0[2], v0[3]); w.z = cvt_pk_bf16(v1[0], v1[1]); w.w = cvt_pk_bf16(v1[2], v1[3]);
                    *(PG8_GAS u32x4*)(base + (size_t)(row0 + ai * HALF + m * 16) * ldc + zc) = w; }
        } else if (mode == 1 || mode == 2 || mode == 5) {
            bf16_t* base = (mode == 5) ? (bf16_t*)O2 - 16 * BM : (bf16_t*)O; const bool sq = (mode == 2);
#pragma unroll
            for (int ai = 0; ai < 2; ++ai)
#pragma unroll
                for (int m = 0; m < 4; ++m) { bf16_t* rowp = base + (size_t)(row0 + ai * HALF + m * 16) * ldc + colb;
#pragma unroll
                    for (int bj = 0; bj < 2; ++bj) { f32x4 v0 = acc[ai][bj][m][0], v1 = acc[ai][bj][m][1];
                        if (sq) {
#pragma unroll
                            for (int e = 0; e < 4; ++e) { const float a = fmaxf(v0[e], 0.f), b = fmaxf(v1[e], 0.f); v0[e] = a * a; v1[e] = b * b; } }
                        u32x4 w; w.x = cvt_pk_bf16(v0[0], v0[1]); w.y = cvt_pk_bf16(v0[2], v0[3]); w.z = cvt_pk_bf16(v1[0], v1[1]); w.w = cvt_pk_bf16(v1[2], v1[3]);
                        *(PG8_GAS u32x4*)(rowp + bj * HALF) = w; } }
        } else if (mode == 3) {
            bf16_t* base = (bf16_t*)O;
#pragma unroll
            for (int bj = 0; bj < 2; ++bj) {
                const int col = colb + bj * HALF, d = col % 192; const bool rope = d >= 128; const int j0 = (d - 128) >> 1;
#pragma unroll
                for (int ai = 0; ai < 2; ++ai)
#pragma unroll
                    for (int m = 0; m < 4; ++m) { const int row = row0 + ai * HALF + m * 16;
                        f32x4 v0 = acc[ai][bj][m][0] * scale, v1 = acc[ai][bj][m][1] * scale;
                        if (rope) { const f32x4 c0 = *(const PG8_GAS f32x4*)(cs + (size_t)row * 64 + 2 * j0), c1 = *(const PG8_GAS f32x4*)(cs + (size_t)row * 64 + 2 * j0 + 4);
                            f32x4 t0, t1;
                            t0[0] = v0[0] * c0[0] - v0[1] * c0[1]; t0[1] = v0[1] * c0[0] + v0[0] * c0[1];
                            t0[2] = v0[2] * c0[2] - v0[3] * c0[3]; t0[3] = v0[3] * c0[2] + v0[2] * c0[3];
                            t1[0] = v1[0] * c1[0] - v1[1] * c1[1]; t1[1] = v1[1] * c1[0] + v1[0] * c1[1];
                            t1[2] = v1[2] * c1[2] - v1[3] * c1[3]; t1[3] = v1[3] * c1[2] + v1[2] * c1[3];
                            v0 = t0; v1 = t1; }
                        u32x4 w; w.x = cvt_pk_bf16(v0[0], v0[1]); w.y = cvt_pk_bf16(v0[2], v0[3]); w.z = cvt_pk_bf16(v1[0], v1[1]); w.w = cvt_pk_bf16(v1[2], v1[3]);
                        *(PG8_GAS u32x4*)(base + (size_t)row * ldc + col) = w; } }
        } else {
            bf16_t* kb = (bf16_t*)O; bf16_t* vb = (bf16_t*)O2; const int h = u.pn, dcol = colb & 127;
#pragma unroll
            for (int ai = 0; ai < 2; ++ai)
#pragma unroll
                for (int m = 0; m < 4; ++m) { const size_t row = (size_t)(row0 + ai * HALF + m * 16);
#pragma unroll
                    for (int bj = 0; bj < 2; ++bj) { const f32x4 v0 = acc[ai][bj][m][0], v1 = acc[ai][bj][m][1];
                        u32x4 w; w.x = cvt_pk_bf16(v0[0], v0[1]); w.y = cvt_pk_bf16(v0[2], v0[3]); w.z = cvt_pk_bf16(v1[0], v1[1]); w.w = cvt_pk_bf16(v1[2], v1[3]);
                        if (bj == 0) *(PG8_GAS u32x4*)(kb + (row * 16 + h) * 192 + dcol) = w; else *(PG8_GAS u32x4*)(vb + row * 2048 + h * 128 + dcol) = w; } }
        }
    }
};

template <class Epi, class Sched, bool ALIGN_EPI = false, bool SP2 = false>
__device__ __forceinline__ void gemm_phase(PG8_LAS unsigned char* lds, const Gemm g, const Sched& S, const Epi& E, const int tid) {
    const int wid = __builtin_amdgcn_readfirstlane(tid >> 6), lane = tid & 63, wr = wid >> 2, wc = wid & 3, fr = lane & 15, fq = lane >> 4;
    const int K = g.K, nt = K / BK;
    unsigned voffA[2], voffB[2];
#pragma unroll
    for (int i = 0; i < 2; ++i) { int R, C; stage_rc(tid * 16 + i * 8192, R, C); const int Rb = Epi::PERM ? ((R & ~31) + perm32(R & 31)) : R;
        voffA[i] = (unsigned)(R * K + C) * 2u; voffB[i] = (unsigned)(Rb * K + C) * 2u; }
    const size_t kstep = (size_t)(BK * 2);
    const size_t hstep = (size_t)HALF * K * 2;
    const size_t tstep = 2 * hstep;
    const unsigned ldsw = (unsigned)wid * 1024u;
    const int aoff = lds_byte(wr * 64 + fr, fq * 8), boff = lds_byte(wc * 32 + fr, fq * 8);
#define PG8_SA(b, h) (((b) * 2 + (h)) * HTB)
#define PG8_SB(b, h) ((4 + (b) * 2 + (h)) * HTB)
#define PG8_STAGE(bufoff, gbase, voff) do { _Pragma("unroll") for (int _i = 0; _i < 2; ++_i) \
        __builtin_amdgcn_global_load_lds((const unsigned*)((const char*)(gbase) + (voff)[_i]), (PG8_LAS unsigned*)(lds + (bufoff) + ldsw + _i * 8192), 16, 0, 0); } while (0)
#define PG8_LDA(dst, b, h) do { _Pragma("unroll") for (int m = 0; m < 4; ++m) _Pragma("unroll") for (int k = 0; k < 2; ++k) dst[m][k] = *(const PG8_LAS bf16x8*)(lds + PG8_SA(b, h) + aoff + m * 2048 + k * 1024); } while (0)
#define PG8_LDB(dst, b, h) do { _Pragma("unroll") for (int n = 0; n < 2; ++n) _Pragma("unroll") for (int k = 0; k < 2; ++k) dst[n][k] = *(const PG8_LAS bf16x8*)(lds + PG8_SB(b, h) + boff + n * 2048 + k * 1024); } while (0)
#define PG8_MMA(ai, bj, At, Bt) do { __builtin_amdgcn_s_setprio(1); _Pragma("unroll") for (int m = 0; m < 4; ++m) _Pragma("unroll") for (int n = 0; n < 2; ++n) _Pragma("unroll") for (int k = 0; k < 2; ++k) \
        acc[ai][bj][m][n] = __builtin_amdgcn_mfma_f32_16x16x32_bf16(Bt[n][k], At[m][k], acc[ai][bj][m][n], 0, 0, 0); __builtin_amdgcn_s_setprio(0); } while (0)
#define PG8_WAIT_V(n) asm volatile("s_waitcnt vmcnt(" #n ")" ::: "memory")
#define PG8_WAIT_L(n) asm volatile("s_waitcnt lgkmcnt(" #n ")" ::: "memory")
#define PG8_BAR __builtin_amdgcn_s_barrier()
#define PG8_SCHED __builtin_amdgcn_sched_barrier(0)
    Unit cur, nxt; int ui = 0;
    if (!S.next(0, cur)) return;
    f32x4 acc[2][2][4][2];
#pragma unroll
    for (int a = 0; a < 2; ++a)
#pragma unroll
        for (int b = 0; b < 2; ++b)
#pragma unroll
            for (int m = 0; m < 4; ++m)
#pragma unroll
                for (int n = 0; n < 2; ++n) acc[a][b][m][n] = (f32x4){0.f, 0.f, 0.f, 0.f};
    bf16x8 At[4][2], B0[2][2], B1[2][2];
    const char* cA = (const char*)g.A + (size_t)cur.pm * tstep; const char* cB = (const char*)g.Bt + (size_t)cur.pn * tstep;
    S.a_ready(cur);
    if constexpr (SP2) {
        PG8_STAGE(PG8_SB(0, 0), cB, voffB); PG8_STAGE(PG8_SB(0, 1), cB + hstep, voffB); PG8_STAGE(PG8_SA(0, 0), cA, voffA); PG8_STAGE(PG8_SA(0, 1), cA + hstep, voffA);
        if (wr == 1) PG8_BAR;
        PG8_WAIT_V(2); PG8_BAR;
        PG8_STAGE(PG8_SB(1, 0), cB + kstep, voffB); PG8_STAGE(PG8_SA(1, 0), cA + kstep, voffA); PG8_STAGE(PG8_SB(1, 1), cB + hstep + kstep, voffB);
        PG8_WAIT_V(6); PG8_BAR;
    } else {
        PG8_STAGE(PG8_SB(0, 0), cB, voffB); PG8_STAGE(PG8_SA(0, 0), cA, voffA); PG8_STAGE(PG8_SB(0, 1), cB + hstep, voffB); PG8_STAGE(PG8_SA(0, 1), cA + hstep, voffA);
        if (wr == 1) PG8_BAR;
        PG8_WAIT_V(4); PG8_BAR;
        PG8_STAGE(PG8_SB(1, 0), cB + kstep, voffB); PG8_STAGE(PG8_SA(1, 0), cA + kstep, voffA); PG8_STAGE(PG8_SB(1, 1), cB + hstep + kstep, voffB);
        PG8_WAIT_V(6); PG8_BAR;
    }
    for (;;) {
        const bool has_next = S.next(ui + 1, nxt);
        const char* nA = has_next ? (const char*)g.A + (size_t)nxt.pm * tstep : cA; const char* nB = has_next ? (const char*)g.Bt + (size_t)nxt.pn * tstep : cB;
        for (int t = 0; t < nt; t += 2) {
            const bool last = (t == nt - 2);
            const char* a1 = cA + (size_t)(t + 1) * kstep;
            const char* a2 = last ? nA : cA + (size_t)(t + 2) * kstep; const char* b2 = last ? nB : cB + (size_t)(t + 2) * kstep;
            const char* a3 = a2 + kstep; const char* b3 = b2 + kstep;
            if (last && has_next) S.a_ready(nxt);
            if constexpr (SP2) {
            PG8_LDB(B0, 0, 0); PG8_LDB(B1, 0, 1); PG8_SCHED; PG8_LDA(At, 0, 0); PG8_STAGE(PG8_SA(1, 1), a1 + hstep, voffA);
            PG8_WAIT_V(8); PG8_WAIT_L(0); PG8_BAR; PG8_MMA(0, 0, At, B0); PG8_MMA(0, 1, At, B1); PG8_BAR; PG8_SCHED;
            PG8_LDA(At, 0, 1); PG8_STAGE(PG8_SB(0, 0), b2, voffB); PG8_STAGE(PG8_SB(0, 1), b2 + hstep, voffB); PG8_STAGE(PG8_SA(0, 0), a2, voffA);
            PG8_WAIT_V(8); PG8_WAIT_L(0); PG8_BAR; PG8_MMA(1, 0, At, B0); PG8_MMA(1, 1, At, B1); PG8_BAR; PG8_SCHED;
            PG8_LDB(B0, 1, 0); PG8_LDB(B1, 1, 1); PG8_SCHED; PG8_LDA(At, 1, 0); PG8_STAGE(PG8_SA(0, 1), a2 + hstep, voffA);
            PG8_WAIT_V(8); PG8_WAIT_L(0); PG8_BAR; PG8_MMA(0, 0, At, B0); PG8_MMA(0, 1, At, B1); PG8_BAR; PG8_SCHED;
            PG8_LDA(At, 1, 1); PG8_STAGE(PG8_SB(1, 0), b3, voffB); PG8_STAGE(PG8_SB(1, 1), b3 + hstep, voffB); PG8_STAGE(PG8_SA(1, 0), a3, voffA);
            PG8_WAIT_V(8); PG8_WAIT_L(0); PG8_BAR; PG8_MMA(1, 0, At, B0); PG8_MMA(1, 1, At, B1); PG8_BAR; PG8_SCHED;
            } else {
            PG8_LDB(B0, 0, 0); PG8_SCHED; PG8_LDA(At, 0, 0); PG8_STAGE(PG8_SA(1, 1), a1 + hstep, voffA);
            PG8_WAIT_L(8); PG8_BAR; PG8_WAIT_L(0); PG8_MMA(0, 0, At, B0); PG8_BAR; PG8_SCHED;
            PG8_LDB(B1, 0, 1); PG8_STAGE(PG8_SB(0, 0), b2, voffB);
            PG8_BAR; PG8_WAIT_L(0); PG8_MMA(0, 1, At, B1); PG8_BAR;
            PG8_LDA(At, 0, 1); PG8_STAGE(PG8_SA(0, 0), a2, voffA);
            PG8_BAR; PG8_WAIT_L(0); PG8_MMA(1, 0, At, B0); PG8_BAR; PG8_SCHED;
            PG8_STAGE(PG8_SB(0, 1), b2 + hstep, voffB);
            PG8_WAIT_V(6); PG8_BAR; PG8_MMA(1, 1, At, B1); PG8_BAR;
            PG8_LDB(B0, 1, 0); PG8_SCHED; PG8_LDA(At, 1, 0); PG8_STAGE(PG8_SA(0, 1), a2 + hstep, voffA);
            PG8_WAIT_L(8); PG8_BAR; PG8_WAIT_L(0); PG8_MMA(0, 0, At, B0); PG8_BAR; PG8_SCHED;
            PG8_LDB(B1, 1, 1); PG8_STAGE(PG8_SB(1, 0), b3, voffB);
            PG8_BAR; PG8_WAIT_L(0); PG8_MMA(0, 1, At, B1); PG8_BAR;
            PG8_LDA(At, 1, 1); PG8_STAGE(PG8_SA(1, 0), a3, voffA);
            PG8_BAR; PG8_WAIT_L(0); PG8_MMA(1, 0, At, B0); PG8_BAR; PG8_SCHED;
            PG8_STAGE(PG8_SB(1, 1), b3 + hstep, voffB);
            PG8_WAIT_V(6); PG8_BAR; PG8_MMA(1, 1, At, B1); PG8_BAR;
            }
        }
        if constexpr (ALIGN_EPI) { if (wr == 0) PG8_BAR; }
        if constexpr (!Epi::AFTER_DRAIN) { E(acc, cur, wr, wc, fr, fq); S.done(cur); }
        if (!has_next) break;
#pragma unroll
        for (int a = 0; a < 2; ++a)
#pragma unroll
            for (int b = 0; b < 2; ++b)
#pragma unroll
                for (int m = 0; m < 4; ++m)
#pragma unroll
                    for (int n = 0; n < 2; ++n) acc[a][b][m][n] = (f32x4){0.f, 0.f, 0.f, 0.f};
        cur = nxt; cA = nA; cB = nB; ++ui;
        if constexpr (ALIGN_EPI) { if (wr == 1) PG8_BAR; }
    }
    PG8_WAIT_V(0);
    if constexpr (!ALIGN_EPI) { if (wr == 0) PG8_BAR; }
    PG8_BAR;
    if constexpr (Epi::AFTER_DRAIN) { E.fused(acc, cur, wr, wc, fr, fq, lds, wid, lane); S.done(cur); }
#undef PG8_SA
#undef PG8_SB
#undef PG8_STAGE
#undef PG8_LDA
#undef PG8_LDB
#undef PG8_MMA
#undef PG8_WAIT_V
#undef PG8_WAIT_L
#undef PG8_BAR
#undef PG8_SCHED
}
}

#define LAS __attribute__((address_space(3)))
typedef unsigned short bf16_t;
typedef short bf16x8 __attribute__((ext_vector_type(8)));
typedef short s16x4 __attribute__((ext_vector_type(4)));
typedef float f32x4 __attribute__((ext_vector_type(4)));
typedef float f32x16 __attribute__((ext_vector_type(16)));
typedef unsigned u32x4 __attribute__((ext_vector_type(4)));
typedef unsigned u32x2 __attribute__((ext_vector_type(2)));

constexpr int DM = 2048, NB = 4, SEQ = 4096, MT = NB * SEQ, NH = 16, DQK = 192, DV = 128, QL = 512, KVL = 512, LATP = 1280, LATN = 1088, DFF = 8192, NMOD = 6 * DM;
constexpr float EPS = 1e-6f;
constexpr size_t MiB = 1u << 20;
constexpr size_t WS_MOD = 1 * MiB, WS_CS = 2 * MiB;
constexpr size_t W_IN = 8 * MiB, W_UQ = 13 * MiB, W_UKV = 16 * MiB, W_O = 20 * MiB, W_CIN = 28 * MiB, W_COUT = 52 * MiB, W_UP = 60 * MiB, W_DN = 124 * MiB;
constexpr size_t WS_H = 192 * MiB, WS_Y = 256 * MiB, WS_LAT = 256 * MiB, WS_CQ = 336 * MiB, WS_CKV = 352 * MiB;
constexpr size_t WS_BIG = 384 * MiB, WS_Q = 384 * MiB, WS_K = 480 * MiB, WS_V = 576 * MiB, WS_XB = 640 * MiB, WS_END = 704 * MiB;
constexpr int LDS_BYTES = 139264;
constexpr int NTHREADS = 512;

__device__ __forceinline__ unsigned pk2(float lo, float hi) { typedef float f2 __attribute__((ext_vector_type(2))); typedef __bf16 b2 __attribute__((ext_vector_type(2))); f2 v = {lo, hi}; b2 b = __builtin_convertvector(v, b2); return __builtin_bit_cast(unsigned, b); }
__device__ __forceinline__ float bflo(unsigned w) { return __uint_as_float(w << 16); }
__device__ __forceinline__ float bfhi(unsigned w) { return __uint_as_float(w & 0xffff0000u); }
__device__ __forceinline__ float shx(float v, int mask, int lane) { return __int_as_float(__builtin_amdgcn_ds_bpermute((lane ^ mask) << 2, __float_as_int(v))); }
__device__ __forceinline__ float wave_sum(float v, int lane) {
#pragma unroll
    for (int o = 32; o >= 1; o >>= 1) v += shx(v, o, lane);
    return v;
}

#define CAS __attribute__((address_space(4)))
struct Params {
    const float* x; const float* c; const int* pos; const float* w_mod; const float* b_mod; const float* norm_g;
    const float* mla_w_in; const float* mla_g_q; const float* mla_g_kv; const float* mla_w_uq; const float* mla_w_ukv; const float* mla_w_o;
    const float* conv_w_in; const float* conv_w; const float* conv_w_out; const float* mlp_w_up; const float* mlp_w_down;
    float* out; unsigned char* ws; int ph_lo, ph_hi, use_cg, pad;
};

#define GASR __attribute__((address_space(1)))
__device__ __forceinline__ void transpose_item(const float* __restrict__ W, int K, int N, bf16_t* __restrict__ WT, int qperm  , LAS float* scr, int item, int lane) {
    const int nblk = N / 64, kb = item / nblk, nb = item % nblk, k0 = 64 * kb, n0 = 64 * nb;
    f32x4 v[16];
    const float* src = W + (size_t)(k0 + (lane >> 4)) * N + n0 + 4 * (lane & 15);
#pragma unroll
    for (int i = 0; i < 16; ++i) v[i] = __builtin_nontemporal_load((const f32x4*)(src + (size_t)(4 * i) * N));
#pragma unroll
    for (int i = 0; i < 16; ++i) { LAS float* d = scr + (4 * i + (lane >> 4)) * 65 + 4 * (lane & 15); d[0] = v[i][0]; d[1] = v[i][1]; d[2] = v[i][2]; d[3] = v[i][3]; }
    asm volatile("s_waitcnt lgkmcnt(0)" ::: "memory");
    const int c = lane & 7;
#pragma unroll
    for (int j = 0; j < 8; ++j) { const int n = (lane >> 3) + 8 * j; const LAS float* s = scr + (8 * c) * 65 + n;
        u32x4 o; o.x = pk2(s[0 * 65], s[1 * 65]); o.y = pk2(s[2 * 65], s[3 * 65]); o.z = pk2(s[4 * 65], s[5 * 65]); o.w = pk2(s[6 * 65], s[7 * 65]);
        int nr = n0 + n;
        if (qperm == 1) { const int hh = nr / 192, d = nr % 192; if (d >= 128) { const int j2 = d - 128; nr = hh * 192 + 128 + ((j2 < 32) ? 2 * j2 : 2 * (j2 - 32) + 1); } }
        else if (qperm == 2) { if (nr < DM) nr += 2 * DM; else { const int u_ = nr >= 2 * DM, ch = nr - (u_ ? 2 * DM : DM); nr = (ch >> 7) * 256 + u_ * 128 + (ch & 127); } }
        *(GASR u32x4*)(WT + (size_t)nr * K + k0 + 8 * c) = o; }
    asm volatile("s_waitcnt lgkmcnt(0)" ::: "memory");
}

__device__ __forceinline__ float inv_freq_f(int j) {
    const int a = j >> 3, b = j & 7;
    const float fb = b == 0 ? 1.0f : b == 1 ? 0.7498942093324559f : b == 2 ? 0.5623413251903491f : b == 3 ? 0.4216965034285822f : b == 4 ? 0.31622776601683794f : b == 5 ? 0.23713737056616552f : b == 6 ? 0.1778279410038923f : 0.1333521432163324f;
    const float fa = a == 0 ? 1.0f : a == 1 ? 0.1f : a == 2 ? 0.01f : 0.001f;
    return fa * fb;
}
__device__ __forceinline__ void sincos_acc(float angf, float& c, float& s) {
    const double ang = (double)angf;
    const double n = __builtin_rint(ang * 0.6366197723675814);
    double rd = __builtin_fma(-n, 1.5707963267948966, ang); rd = __builtin_fma(-n, 6.123233995736766e-17, rd);
    const float r = (float)rd, z = r * r;
    const float sr = r + r * z * (-1.6666654611e-1f + z * (8.3321608736e-3f + z * -1.9515295891e-4f));
    const float cr = 1.0f - 0.5f * z + z * z * (4.166664568298827e-2f + z * (-1.388731625493765e-3f + z * 2.443315711809948e-5f));
    const int q = ((int)n) & 3;
    s = (q == 0) ? sr : (q == 1) ? cr : (q == 2) ? -sr : -cr;
    c = (q == 0) ? cr : (q == 1) ? -sr : (q == 2) ? -cr : sr;
}

__device__ __forceinline__ void p0_prologue(const CAS Params& P, unsigned char* ws, LAS unsigned char* lds, int tid, int lane, int wave, int G, int bid) {
    float* mod = (float*)(ws + WS_MOD); float* cs = (float*)(ws + WS_CS);
    for (int i = bid * NTHREADS + tid; i < MT * 32; i += G * NTHREADS) { const int t = i >> 5, j = i & 31;
        const float ang = (float)P.pos[t] * inv_freq_f(j); float c_, s_; sincos_acc(ang, c_, s_); cs[2 * i] = c_; cs[2 * i + 1] = s_; }
    LAS float* condL = (LAS float*)lds; LAS float* red = (LAS float*)(lds + 32768);
    for (int i = tid; i < NB * DM; i += NTHREADS) { const float v = P.c[i]; condL[i] = v / (1.f + __expf(-v)); }
    __syncthreads();
    for (int unit = bid; unit < 2 * (NMOD / 32); unit += G) {
        const int layer = unit / (NMOD / 32), cb = unit % (NMOD / 32);
        const float* W = P.w_mod + (size_t)layer * DM * NMOD + cb * 32 + 4 * (lane & 7);
        const int kph = wave * 8 + (lane >> 3);
        f32x4 acc[4];
#pragma unroll
        for (int b = 0; b < 4; ++b) acc[b] = (f32x4){0.f, 0.f, 0.f, 0.f};
#pragma unroll 16
        for (int kk = 0; kk < 32; ++kk) { const int k = kph + 64 * kk; const f32x4 w = __builtin_nontemporal_load((const f32x4*)(W + (size_t)k * NMOD));
#pragma unroll
            for (int b = 0; b < 4; ++b) acc[b] += w * condL[b * DM + k]; }
#pragma unroll
        for (int b = 0; b < 4; ++b) *(LAS f32x4*)(red + ((kph * 4 + b) * 32 + 4 * (lane & 7))) = acc[b];
        __syncthreads();
        if (tid < 128) { const int b = tid >> 5, cc = tid & 31; float s = 0.f;
#pragma unroll 8
            for (int kp = 0; kp < 64; ++kp) s += red[(kp * 4 + b) * 32 + cc];
            mod[(size_t)(layer * 4 + b) * NMOD + cb * 32 + cc] = s + P.b_mod[layer * NMOD + cb * 32 + cc]; }
        __syncthreads();
    }
    LAS float* scr = (LAS float*)(lds + wave * 16640);
    const int gw = bid * 8 + wave, NGW = G * 8;
    constexpr int I_IN = (DM / 64) * (LATN / 64), I_UQ = (QL / 64) * (NH * DQK / 64), I_UKV = (KVL / 64) * (NH * 256 / 64), I_O = (DM / 64) * (DM / 64),
                  I_CIN = (DM / 64) * (3 * DM / 64), I_UP = (DM / 64) * (DFF / 64), I_DN = (DFF / 64) * (DM / 64);
    constexpr int NITEMS = I_IN + I_UQ + I_UKV + I_O + I_CIN + I_O + 2 * I_UP + I_DN;
    for (int it = gw; it < NITEMS; it += NGW) {
        int r = it;
        if (r < I_IN) { transpose_item(P.mla_w_in, DM, LATN, (bf16_t*)(ws + W_IN), 0, scr, r, lane); continue; } r -= I_IN;
        if (r < I_UQ) { transpose_item(P.mla_w_uq, QL, NH * DQK, (bf16_t*)(ws + W_UQ), 1, scr, r, lane); continue; } r -= I_UQ;
        if (r < I_UKV) { transpose_item(P.mla_w_ukv, KVL, NH * 256, (bf16_t*)(ws + W_UKV), 0, scr, r, lane); continue; } r -= I_UKV;
        if (r < I_O) { transpose_item(P.mla_w_o, DM, DM, (bf16_t*)(ws + W_O), 0, scr, r, lane); continue; } r -= I_O;
        if (r < I_CIN) { transpose_item(P.conv_w_in, DM, 3 * DM, (bf16_t*)(ws + W_CIN), 2, scr, r, lane); continue; } r -= I_CIN;
        if (r < I_O) { transpose_item(P.conv_w_out, DM, DM, (bf16_t*)(ws + W_COUT), 0, scr, r, lane); continue; } r -= I_O;
        if (r < 2 * I_UP) { const int l = r / I_UP; transpose_item(P.mlp_w_up + (size_t)l * DM * DFF, DM, DFF, (bf16_t*)(ws + W_UP) + (size_t)l * DM * DFF, 0, scr, r % I_UP, lane); continue; } r -= 2 * I_UP;
        { transpose_item(P.mlp_w_down, DFF, DM, (bf16_t*)(ws + W_DN), 0, scr, r, lane); }
    }
}

__device__ __forceinline__ void deferred_convert(const CAS Params& P, unsigned char* ws, LAS unsigned char* lds, int lane, int wave, int G, int bid) {
    constexpr int I_DN = (DFF / 64) * (DM / 64);
    const int nwg = (MT / 256) * (LATP / 256), rounds = (nwg + G - 1) / G, nlight = rounds * G - nwg, first_light = G - nlight;
    int gwl, ngwl;
    if (nlight > 0) { if (bid < first_light) return; gwl = (bid - first_light) * 8 + wave; ngwl = nlight * 8; } else { gwl = bid * 8 + wave; ngwl = G * 8; }
    LAS float* scr = (LAS float*)(lds + wave * 16640);
    for (int it = gwl; it < I_DN; it += ngwl) transpose_item(P.mlp_w_down + (size_t)DM * DFF, DFF, DM, (bf16_t*)(ws + W_DN) + (size_t)DM * DFF, 0, scr, it, lane);
}

__device__ __forceinline__ void row_prenorm(const float* __restrict__ x, const float* __restrict__ g, const float* __restrict__ modl  , int shi, int sci, bf16_t* __restrict__ h, int lane, int gw, int NGW) {
    for (int m0 = gw * 8; m0 < MT; m0 += NGW * 8) {
        const int b = m0 / SEQ; const float* md = modl + (size_t)b * NMOD;
        f32x4 A[8], B[8];
#pragma unroll
        for (int j = 0; j < 8; ++j) { const int c = 4 * lane + 256 * j; const f32x4 gg = *(const GASR f32x4*)(g + c), sc = *(const GASR f32x4*)(md + sci * DM + c); A[j] = gg * (sc + 1.f); B[j] = *(const GASR f32x4*)(md + shi * DM + c); }
#pragma unroll 1
        for (int r = 0; r < 8; ++r) { const size_t row = (size_t)(m0 + r);
            f32x4 v[8]; float ss = 0.f;
#pragma unroll
            for (int j = 0; j < 8; ++j) { v[j] = *(const GASR f32x4*)(x + row * DM + 4 * lane + 256 * j); ss += (v[j][0] * v[j][0] + v[j][1] * v[j][1]) + (v[j][2] * v[j][2] + v[j][3] * v[j][3]); }
            const float rstd = 1.0f / sqrtf(wave_sum(ss, lane) * (1.0f / DM) + EPS);
#pragma unroll
            for (int j = 0; j < 8; ++j) { const f32x4 o = v[j] * rstd * A[j] + B[j]; u32x2 w; w.x = pk2(o[0], o[1]); w.y = pk2(o[2], o[3]); *(GASR u32x2*)(h + row * DM + 4 * lane + 256 * j) = w; }
        }
    }
}
__device__ __forceinline__ void row_resid(const float* __restrict__ xin_f, const bf16_t* xin_b, const bf16_t* __restrict__ y, float* __restrict__ xout_f, bf16_t* xout_b, bf16_t* __restrict__ h,
                                          const float* __restrict__ gpost, const float* __restrict__ gate  , const float* __restrict__ gpre, const float* __restrict__ sc, const float* __restrict__ sh,
                                          int lane, int gw, int NGW) {
    for (int m0 = gw * 8; m0 < MT; m0 += NGW * 8) {
        const int b = m0 / SEQ;
        f32x4 Gv[8];
#pragma unroll
        for (int j = 0; j < 8; ++j) { const int c = 4 * lane + 256 * j; Gv[j] = *(const GASR f32x4*)(gpost + c) * *(const GASR f32x4*)(gate + (size_t)b * NMOD + c); }
#pragma unroll 1
        for (int r = 0; r < 8; ++r) { const size_t row = (size_t)(m0 + r);
            f32x4 v[8], xv[8]; float ss = 0.f;
#pragma unroll
            for (int j = 0; j < 8; ++j) { const u32x2 yw = *(const GASR u32x2*)(y + row * DM + 4 * lane + 256 * j); v[j] = (f32x4){bflo(yw.x), bfhi(yw.x), bflo(yw.y), bfhi(yw.y)};
                ss += (v[j][0] * v[j][0] + v[j][1] * v[j][1]) + (v[j][2] * v[j][2] + v[j][3] * v[j][3]); }
            if (xin_f) {
#pragma unroll
                for (int j = 0; j < 8; ++j) xv[j] = *(const GASR f32x4*)(xin_f + row * DM + 4 * lane + 256 * j);
            } else {
#pragma unroll
                for (int j = 0; j < 8; ++j) { const u32x2 xw = *(const GASR u32x2*)(xin_b + row * DM + 4 * lane + 256 * j); xv[j] = (f32x4){bflo(xw.x), bfhi(xw.x), bflo(xw.y), bfhi(xw.y)}; }
            }
            const float rstd = 1.0f / sqrtf(wave_sum(ss, lane) * (1.0f / DM) + EPS);
            float s2 = 0.f;
#pragma unroll
            for (int j = 0; j < 8; ++j) { xv[j] = xv[j] + v[j] * rstd * Gv[j]; s2 += (xv[j][0] * xv[j][0] + xv[j][1] * xv[j][1]) + (xv[j][2] * xv[j][2] + xv[j][3] * xv[j][3]); }
            if (xout_f) {
#pragma unroll
                for (int j = 0; j < 8; ++j) *(GASR f32x4*)(xout_f + row * DM + 4 * lane + 256 * j) = xv[j];
            } else {
#pragma unroll
                for (int j = 0; j < 8; ++j) { u32x2 w; w.x = pk2(xv[j][0], xv[j][1]); w.y = pk2(xv[j][2], xv[j][3]); *(GASR u32x2*)(xout_b + row * DM + 4 * lane + 256 * j) = w; }
            }
            if (h) { const float rs2 = 1.0f / sqrtf(wave_sum(s2, lane) * (1.0f / DM) + EPS);
#pragma unroll
                for (int j = 0; j < 8; ++j) { const int c = 4 * lane + 256 * j;
                    const f32x4 A = *(const GASR f32x4*)(gpre + c) * (*(const GASR f32x4*)(sc + (size_t)b * NMOD + c) + 1.f), B = *(const GASR f32x4*)(sh + (size_t)b * NMOD + c);
                    const f32x4 o = xv[j] * rs2 * A + B; u32x2 w; w.x = pk2(o[0], o[1]); w.y = pk2(o[2], o[3]); *(GASR u32x2*)(h + row * DM + c) = w; } }
        }
    }
}
__device__ __forceinline__ void row_latent(const bf16_t* __restrict__ lat, const float* __restrict__ gq, const float* __restrict__ gkv, const float* __restrict__ cs,
                                           bf16_t* __restrict__ cq, bf16_t* __restrict__ ckv, bf16_t* __restrict__ Kb, int lane, int gw, int NGW) {
    for (int row = gw; row < MT; row += NGW) { const bf16_t* lr = lat + (size_t)row * LATP;
#pragma unroll
        for (int part = 0; part < 2; ++part) { const bf16_t* src = lr + part * 512; const float* gg = part ? gkv : gq; bf16_t* dst = (part ? ckv : cq) + (size_t)row * 512;
            const u32x2 r0 = *(const GASR u32x2*)(src + 4 * lane), r1 = *(const GASR u32x2*)(src + 256 + 4 * lane);
            const f32x4 a0 = {bflo(r0.x), bfhi(r0.x), bflo(r0.y), bfhi(r0.y)}, a1 = {bflo(r1.x), bfhi(r1.x), bflo(r1.y), bfhi(r1.y)};
            const float ss = (a0[0] * a0[0] + a0[1] * a0[1]) + (a0[2] * a0[2] + a0[3] * a0[3]) + (a1[0] * a1[0] + a1[1] * a1[1]) + (a1[2] * a1[2] + a1[3] * a1[3]);
            const float rstd = 1.0f / sqrtf(wave_sum(ss, lane) * (1.0f / 512.f) + EPS);
            const f32x4 o0 = a0 * rstd * *(const GASR f32x4*)(gg + 4 * lane), o1 = a1 * rstd * *(const GASR f32x4*)(gg + 256 + 4 * lane);
            u32x2 w0, w1; w0.x = pk2(o0[0], o0[1]); w0.y = pk2(o0[2], o0[3]); w1.x = pk2(o1[0], o1[1]); w1.y = pk2(o1[2], o1[3]);
            *(GASR u32x2*)(dst + 4 * lane) = w0; *(GASR u32x2*)(dst + 256 + 4 * lane) = w1; }
        if (lane < 32) { const float x1 = __uint_as_float((unsigned)lr[1024 + lane] << 16), x2 = __uint_as_float((unsigned)lr[1056 + lane] << 16), c_ = cs[(size_t)row * 64 + 2 * lane], s_ = cs[(size_t)row * 64 + 2 * lane + 1];
            const unsigned w = pk2(x1 * c_ - x2 * s_, x2 * c_ + x1 * s_);
#pragma unroll
            for (int hh = 0; hh < NH; ++hh) *(GASR unsigned*)(Kb + ((size_t)row * NH + hh) * DQK + 128 + 2 * lane) = w; }
    }
}
__device__ __forceinline__ void row_conv(const bf16_t* __restrict__ bb, const bf16_t* __restrict__ zz, const float* __restrict__ cw, bf16_t* __restrict__ gz, int lane, int gw, int NGW) {
    for (int m0 = gw * 8; m0 < MT; m0 += NGW * 8) {
        const int s0 = m0 % SEQ;
#pragma unroll 1
        for (int j = 0; j < 4; ++j) { const int c0 = 8 * lane + 512 * j;
            float w0[8], w1[8], w2[8], zm2[8], zm1[8];
            { const f32x4 a = *(const GASR f32x4*)(cw + c0), b = *(const GASR f32x4*)(cw + c0 + 4), c = *(const GASR f32x4*)(cw + DM + c0), d = *(const GASR f32x4*)(cw + DM + c0 + 4), e = *(const GASR f32x4*)(cw + 2 * DM + c0), f = *(const GASR f32x4*)(cw + 2 * DM + c0 + 4);
#pragma unroll
              for (int i = 0; i < 4; ++i) { w0[i] = a[i]; w0[4 + i] = b[i]; w1[i] = c[i]; w1[4 + i] = d[i]; w2[i] = e[i]; w2[4 + i] = f[i]; } }
#pragma unroll
            for (int i = 0; i < 8; ++i) { zm2[i] = 0.f; zm1[i] = 0.f; }
            if (s0 >= 2) { const u32x4 za = *(const GASR u32x4*)(zz + (size_t)(m0 - 2) * DM + c0), zb = *(const GASR u32x4*)(zz + (size_t)(m0 - 1) * DM + c0);
#pragma unroll
                for (int i = 0; i < 4; ++i) { zm2[2 * i] = bflo(za[i]); zm2[2 * i + 1] = bfhi(za[i]); zm1[2 * i] = bflo(zb[i]); zm1[2 * i + 1] = bfhi(zb[i]); } }
#pragma unroll
            for (int r = 0; r < 8; ++r) { const size_t off = (size_t)(m0 + r) * DM + c0; const u32x4 bv = *(const GASR u32x4*)(bb + off), zv = *(const GASR u32x4*)(zz + off);
                float z[8], o[8];
#pragma unroll
                for (int i = 0; i < 4; ++i) { z[2 * i] = bflo(zv[i]); z[2 * i + 1] = bfhi(zv[i]); }
#pragma unroll
                for (int i = 0; i < 4; ++i) { o[2 * i] = bflo(bv[i]) * (w0[2 * i] * zm2[2 * i] + w1[2 * i] * zm1[2 * i] + w2[2 * i] * z[2 * i]); o[2 * i + 1] = bfhi(bv[i]) * (w0[2 * i + 1] * zm2[2 * i + 1] + w1[2 * i + 1] * zm1[2 * i + 1] + w2[2 * i + 1] * z[2 * i + 1]); }
                u32x4 w; w.x = pk2(o[0], o[1]); w.y = pk2(o[2], o[3]); w.z = pk2(o[4], o[5]); w.w = pk2(o[6], o[7]);
                *(GASR u32x4*)(gz + off) = w;
#pragma unroll
                for (int i = 0; i < 8; ++i) { zm2[i] = zm1[i]; zm1[i] = z[i]; } }
        }
    }
}

namespace att {
constexpr int KSTR = 400, VSTR = 320, KT_BYTES = 64 * KSTR, VT_BYTES = 64 * VSTR, STG = KT_BYTES + VT_BYTES, NSTG = 3;
static_assert(NSTG * STG <= 138240, "attention LDS");
#define GAS __attribute__((address_space(1)))
#define ABAR() do { asm volatile("s_waitcnt lgkmcnt(0)" ::: "memory"); __builtin_amdgcn_s_barrier(); asm volatile("" ::: "memory"); } while (0)
#define MFMA32(a, b, c) __builtin_amdgcn_mfma_f32_32x32x16_bf16((a), (b), (c), 0, 0, 0)
__device__ __forceinline__ float max3f(float a, float b, float c) { float r; asm("v_max3_f32 %0, %1, %2, %3" : "=v"(r) : "v"(a), "v"(b), "v"(c)); return r; }
__device__ __forceinline__ s16x4 vtr(const LAS unsigned char* p) { typedef short v4i16_t __attribute__((ext_vector_type(4))); return __builtin_bit_cast(s16x4, __builtin_amdgcn_ds_read_tr16_b64_v4i16((LAS v4i16_t*)p)); }
__device__ __forceinline__ bf16x8 pack8(const f32x16& p, int o) { u32x4 w; w.x = pk2(p[o], p[o + 1]); w.y = pk2(p[o + 2], p[o + 3]); w.z = pk2(p[o + 4], p[o + 5]); w.w = pk2(p[o + 6], p[o + 7]); return __builtin_bit_cast(bf16x8, w); }

__device__ __forceinline__ void attn_unit(int b, int h, int qb, const bf16_t* __restrict__ Q, const bf16_t* __restrict__ Kb, const bf16_t* __restrict__ Vb, bf16_t* __restrict__ O, LAS unsigned char* lds, const int tid) {
    const int lane = tid & 63, wid = __builtin_amdgcn_readfirstlane(tid >> 6), r32 = lane & 31, hi = lane >> 5, late = wid >> 2;
    const size_t tok0 = (size_t)b * SEQ;
    const int qw0 = qb * 256 + wid * 32;
    const bf16_t* qp = Q + (tok0 + qw0) * (NH * DQK) + h * DQK + (unsigned)(r32 * (NH * DQK) + hi * 8);
    bf16x8 qf[12];
#pragma unroll
    for (int d0 = 0; d0 < 12; ++d0) qf[d0] = *(const GAS bf16x8*)(qp + d0 * 16);
    const bf16_t* kgb = Kb + (tok0 * NH + h) * DQK; const bf16_t* vgb = Vb + tok0 * (NH * DV) + h * DV;
    const unsigned kgo = (unsigned)((tid >> 3) * (NH * DQK) + (tid & 7) * 8), vgo = (unsigned)((tid >> 3) * (NH * DV) + (tid & 7) * 8);
    LAS unsigned char* klp = lds + (tid >> 3) * KSTR + (tid & 7) * 16;
    LAS unsigned char* vlp = lds + KT_BYTES + (tid >> 3) * VSTR + (tid & 7) * 16;
    const int kfo = r32 * KSTR + hi * 16;
    const int vfo = KT_BYTES + (4 * hi + ((lane & 15) >> 2)) * VSTR + (16 * ((lane >> 4) & 1) + 4 * (lane & 3)) * 2;
    f32x16 o[4];
#pragma unroll
    for (int i = 0; i < 4; ++i)
#pragma unroll
        for (int r = 0; r < 16; ++r) o[i][r] = 0.f;
    float m = -1e30f, l = 0.f;
    const int NT = 4 * (qb + 1);
    u32x4 kr[3], vr[2];
#pragma unroll
    for (int i = 0; i < 3; ++i) kr[i] = *(const GAS u32x4*)(kgb + (kgo + i * 64));
#pragma unroll
    for (int i = 0; i < 2; ++i) vr[i] = *(const GAS u32x4*)(vgb + (vgo + i * 64));
#pragma unroll
    for (int i = 0; i < 3; ++i) *(LAS u32x4*)(klp + i * 128) = kr[i];
#pragma unroll
    for (int i = 0; i < 2; ++i) *(LAS u32x4*)(vlp + i * 128) = vr[i];
    if (NT > 1) {
#pragma unroll
        for (int i = 0; i < 3; ++i) kr[i] = *(const GAS u32x4*)(kgb + (size_t)64 * (NH * DQK) + (kgo + i * 64));
#pragma unroll
        for (int i = 0; i < 2; ++i) vr[i] = *(const GAS u32x4*)(vgb + (size_t)64 * (NH * DV) + (vgo + i * 64)); }
    ABAR();
    if (late) { __builtin_amdgcn_s_setprio(1); ABAR(); }
    bf16x8 pf[4];
#pragma unroll
    for (int i = 0; i < 4; ++i) pf[i] = (bf16x8){0, 0, 0, 0, 0, 0, 0, 0};
    int sprev = 2 * STG, scur = 0, snext = STG;
#pragma unroll 1
    for (int t = 0; ; ++t) {
        const bool more = (t + 1 < NT);
        f32x16 s0, s1;
        if (t >= 1 && 64 * (t - 1) <= qw0 + 31) {
            const LAS unsigned char* vp = lds + sprev + vfo;
            s16x4 vA[8], vB[8];
#define LDV(dst, ks) do { _Pragma("unroll") for (int db = 0; db < 4; ++db) { dst[2 * db] = vtr(vp + (16 * (ks)) * VSTR + 64 * db); dst[2 * db + 1] = vtr(vp + (16 * (ks) + 8) * VSTR + 64 * db); } } while (0)
#define PVM(srcv, ks) do { _Pragma("unroll") for (int db = 0; db < 4; ++db) o[db] = MFMA32(__builtin_shufflevector(srcv[2 * db], srcv[2 * db + 1], 0, 1, 2, 3, 4, 5, 6, 7), pf[ks], o[db]); } while (0)
            LDV(vA, 0); __builtin_amdgcn_sched_barrier(0);
            LDV(vB, 1); __builtin_amdgcn_sched_barrier(0); PVM(vA, 0); __builtin_amdgcn_sched_barrier(0);
            LDV(vA, 2); __builtin_amdgcn_sched_barrier(0); PVM(vB, 1); __builtin_amdgcn_sched_barrier(0);
            LDV(vB, 3); __builtin_amdgcn_sched_barrier(0); PVM(vA, 2); __builtin_amdgcn_sched_barrier(0);
            PVM(vB, 3); __builtin_amdgcn_sched_barrier(0);
#undef LDV
#undef PVM
        }
        if (t < NT && 64 * t <= qw0 + 31) {
            const LAS unsigned char* kp = lds + scur + kfo;
#pragma unroll
            for (int r = 0; r < 16; ++r) { s0[r] = 0.f; s1[r] = 0.f; }
            bf16x8 kA[2], kB[2], kC[2];
#define LDK(dst, d) do { dst[0] = *(const LAS bf16x8*)(kp + (d) * 32); dst[1] = *(const LAS bf16x8*)(kp + 32 * KSTR + (d) * 32); } while (0)
#define SKM(srck, d) do { s0 = MFMA32(srck[0], qf[d], s0); s1 = MFMA32(srck[1], qf[d], s1); } while (0)
#define SB() __builtin_amdgcn_sched_barrier(0)
            LDK(kA, 0); LDK(kB, 1); SB();
            LDK(kC, 2); SB(); SKM(kA, 0); SB();
            LDK(kA, 3); SB(); SKM(kB, 1); SB();
            LDK(kB, 4); SB(); SKM(kC, 2); SB();
            LDK(kC, 5); SB(); SKM(kA, 3); SB();
            LDK(kA, 6); SB(); SKM(kB, 4); SB();
            LDK(kB, 7); SB(); SKM(kC, 5); SB();
            LDK(kC, 8); SB(); SKM(kA, 6); SB();
            LDK(kA, 9); SB(); SKM(kB, 7); SB();
            LDK(kB, 10); SB(); SKM(kC, 8); SB();
            LDK(kC, 11); SB(); SKM(kA, 9); SB();
            SKM(kB, 10); SB(); SKM(kC, 11); SB();
#undef LDK
#undef SKM
#undef SB
        }
        if (more) { LAS unsigned char* kl = klp + snext; LAS unsigned char* vl = vlp + snext;
#pragma unroll
            for (int i = 0; i < 3; ++i) *(LAS u32x4*)(kl + i * 128) = kr[i];
#pragma unroll
            for (int i = 0; i < 2; ++i) *(LAS u32x4*)(vl + i * 128) = vr[i]; }
        if (t == NT) break;
        ABAR();
        if (t + 2 < NT) { const bf16_t* kg = kgb + (size_t)(t + 2) * 64 * (NH * DQK); const bf16_t* vg = vgb + (size_t)(t + 2) * 64 * (NH * DV);
#pragma unroll
            for (int i = 0; i < 3; ++i) kr[i] = *(const GAS u32x4*)(kg + (kgo + i * 64));
#pragma unroll
            for (int i = 0; i < 2; ++i) vr[i] = *(const GAS u32x4*)(vg + (vgo + i * 64)); }
        if (64 * t <= qw0 + 31) {
            if (64 * t + 63 > qw0) { const int qpos = qw0 + r32, kb = 64 * t + 4 * hi;
#pragma unroll
                for (int r = 0; r < 16; ++r) { const int key = kb + (r & 3) + 8 * (r >> 2); if (key > qpos) s0[r] = -1e30f; if (key + 32 > qpos) s1[r] = -1e30f; } }
            float mxa = max3f(s0[0], s0[1], s1[0]), mxb = max3f(s0[2], s0[3], s1[1]); mxa = max3f(mxa, s1[2], s1[3]);
#pragma unroll
            for (int r = 4; r < 16; r += 4) { mxa = max3f(mxa, s0[r], s0[r + 1]); mxb = max3f(mxb, s0[r + 2], s0[r + 3]); mxa = max3f(mxa, s1[r], s1[r + 1]); mxb = max3f(mxb, s1[r + 2], s1[r + 3]); }
            float mx = max3f(mxa, mxb, mxb);
            { auto rr_ = __builtin_amdgcn_permlane32_swap(__float_as_uint(mx), __float_as_uint(mx), false, false); mx = fmaxf(__uint_as_float(rr_[0]), __uint_as_float(rr_[1])); }
            const bool bump = mx > m + 8.f;
            if (__any(bump)) { const float mnew = bump ? mx : m, alpha = __builtin_amdgcn_exp2f(m - mnew); m = mnew; l *= alpha;
#pragma unroll
                for (int i = 0; i < 4; ++i)
#pragma unroll
                    for (int r = 0; r < 16; ++r) o[i][r] *= alpha; }
#pragma unroll
            for (int r = 0; r < 16; ++r) { s0[r] -= m; s1[r] -= m; }
            asm volatile("" : "+v"(s0), "+v"(s1));
#pragma unroll
            for (int r = 0; r < 16; ++r) { s0[r] = __builtin_amdgcn_exp2f(s0[r]); s1[r] = __builtin_amdgcn_exp2f(s1[r]); }
            asm volatile("" : "+v"(s0), "+v"(s1));
            { float a0 = s0[0] + s1[0], a1 = s0[1] + s1[1], a2 = s0[2] + s1[2], a3 = s0[3] + s1[3];
#pragma unroll
              for (int r = 4; r < 16; r += 4) { a0 += s0[r] + s1[r]; a1 += s0[r + 1] + s1[r + 1]; a2 += s0[r + 2] + s1[r + 2]; a3 += s0[r + 3] + s1[r + 3]; }
              l += (a0 + a1) + (a2 + a3); }
            pf[0] = pack8(s0, 0); pf[1] = pack8(s0, 8); pf[2] = pack8(s1, 0); pf[3] = pack8(s1, 8);
        }
        ABAR();
        { const int tmp = sprev; sprev = scur; scur = snext; snext = tmp; }
    }
    if (!late) ABAR();
    ABAR();
    __builtin_amdgcn_s_setprio(0);
    const float lt = l + shx(l, 32, lane), inv = 1.0f / lt;
    int lane2 = lane; asm volatile("" : "+v"(lane2));
    const int hi2 = lane2 >> 5;
    bf16_t* op = O + (tok0 + qw0) * (NH * DV) + h * DV + (unsigned)((lane2 & 31) * (NH * DV) + 8 * hi2);
#pragma unroll
    for (int db = 0; db < 4; ++db)
#pragma unroll
        for (int j = 0; j < 2; ++j) {
            const unsigned g0x = pk2(o[db][8 * j] * inv, o[db][8 * j + 1] * inv), g0y = pk2(o[db][8 * j + 2] * inv, o[db][8 * j + 3] * inv);
            const unsigned g1x = pk2(o[db][8 * j + 4] * inv, o[db][8 * j + 5] * inv), g1y = pk2(o[db][8 * j + 6] * inv, o[db][8 * j + 7] * inv);
            const unsigned sx = hi2 ? g0x : g1x, sy = hi2 ? g0y : g1y;
            const auto px = __builtin_amdgcn_permlane32_swap(sx, sx, false, false); const auto py = __builtin_amdgcn_permlane32_swap(sy, sy, false, false);
            const unsigned rx = hi2 ? px[0] : px[1], ry = hi2 ? py[0] : py[1];
            u32x4 w; w.x = hi2 ? rx : g0x; w.y = hi2 ? ry : g0y; w.z = hi2 ? g1x : rx; w.w = hi2 ? g1y : ry;
            *(GAS u32x4*)(op + 32 * db + 16 * j) = w; }
}
}

typedef __attribute__((address_space(1))) unsigned gu32;
#define XB_TMO      128
#define XB_XCNT(j)  (256  + 64 * (j))
#define XB_XSUB(j)  (1280 + 64 * (j))
#define XB_XGEN(j)  (2304 + 64 * (j))
#define XB_TOP      3328
#define XB_TOPGEN   3392
#define XCD_BAR_WORDS 3456
#define XB_SPIN_CAP (1u << 18)

__device__ __forceinline__ unsigned xb_ld(unsigned* p)              { return __hip_atomic_load(p, __ATOMIC_RELAXED, __HIP_MEMORY_SCOPE_AGENT); }
__device__ __forceinline__ unsigned xb_add(unsigned* p, unsigned v) { return __hip_atomic_fetch_add(p, v, __ATOMIC_RELAXED, __HIP_MEMORY_SCOPE_AGENT); }
__device__ __forceinline__ unsigned xb_xcc_id() { return (unsigned)__builtin_amdgcn_s_getreg((3 << 11) | 20) & 0xFu; }
#define XB_SPIN(cond, bar) do { unsigned _sp = 0; while (cond) { __builtin_amdgcn_s_sleep(1); \
    if ((++_sp & 255u) == 0u) { if (xb_ld(&(bar)[XB_TMO])) break; if (_sp > XB_SPIN_CAP) { atomicAdd(&(bar)[XB_TMO], 1u); break; } } } } while (0)

struct XcdBarrier {
    unsigned* bar; unsigned x;
    volatile LAS unsigned* st;
};

__device__ __forceinline__ XcdBarrier xcd_barrier_post(unsigned* bar, volatile LAS unsigned* st) {
    XcdBarrier b; b.bar = bar; b.x = xb_xcc_id(); b.st = st;
    if (threadIdx.x == 0) (void)xb_add(&bar[XB_XCNT(b.x)], 1u);
    return b;
}
__device__ __forceinline__ void xcd_barrier_complete(unsigned* bar, unsigned x, unsigned& nloc, unsigned& nx) {
    const unsigned G = gridDim.x * gridDim.y * gridDim.z;
    unsigned sum, cnt, mine, sp = 0u;
    for (;;) {
        sum = 0u; cnt = 0u; mine = 0u;
#pragma unroll
        for (unsigned j = 0; j < 16; ++j) { const unsigned c = xb_ld(&bar[XB_XCNT(j)]); sum += c; cnt += (c > 0u) ? 1u : 0u; mine = (j == x) ? c : mine; }
        if (sum == G) break;
        __builtin_amdgcn_s_sleep(1);
        if ((++sp & 255u) == 0u) { if (xb_ld(&bar[XB_TMO])) break; if (sp > XB_SPIN_CAP) { atomicAdd(&bar[XB_TMO], 1u); break; } }
    }
    nloc = mine > 0u ? mine : 1u; nx = cnt > 0u ? cnt : 1u;
}

__device__ __forceinline__ void xcd_barrier(const XcdBarrier& b) {
    asm volatile("s_waitcnt vmcnt(0)" ::: "memory");
    __syncthreads();
    if (threadIdx.x == 0) {
        unsigned* bar = b.bar;
        __builtin_amdgcn_s_waitcnt(0);
        unsigned nloc = b.st[0], nx = b.st[1];
        if (nloc == 0u) { xcd_barrier_complete(bar, b.x, nloc, nx); b.st[0] = nloc; b.st[1] = nx; }
        const unsigned old = xb_add(&bar[XB_XSUB(b.x)], 1u);
        const unsigned gen = old / nloc;
        if (old + 1u == (gen + 1u) * nloc) {
            __builtin_amdgcn_fence(__ATOMIC_RELEASE, "agent");
            asm volatile("s_waitcnt vmcnt(0)" ::: "memory");
            const unsigned og = xb_add(&bar[XB_TOP], 1u);
            const unsigned tg = og / nx;
            if (og + 1u == (tg + 1u) * nx) xb_add(&bar[XB_TOPGEN], 1u);
            else XB_SPIN(xb_ld(&bar[XB_TOPGEN]) == tg, bar);
            __builtin_amdgcn_fence(__ATOMIC_ACQUIRE, "agent");
            xb_add(&bar[XB_XGEN(b.x)], 1u);
            asm volatile("s_waitcnt vmcnt(0)" ::: "memory");
        } else {
            XB_SPIN(xb_ld(&bar[XB_XGEN(b.x)]) == gen, bar);
            __builtin_amdgcn_fence(__ATOMIC_ACQUIRE, "agent");
            asm volatile("s_waitcnt vmcnt(0)" ::: "memory");
        }
    }
    __syncthreads();
}

__global__ void __launch_bounds__(NTHREADS) fwd_megakernel(Params P0_) {
    extern __shared__ __attribute__((aligned(16))) unsigned char lds_raw[];
    LAS unsigned char* lds = (LAS unsigned char*)lds_raw;
    cg::grid_group grid = cg::this_grid();
    const float QSCALE = 0.07216878364870322f * 1.4426950408889634f;
    volatile LAS unsigned* bst = (volatile LAS unsigned*)(lds + 138240);
    if (threadIdx.x < 4) bst[threadIdx.x] = 0u;
    __syncthreads();
    const XcdBarrier xbar = xcd_barrier_post((unsigned*)P0_.ws, bst);

#ifndef DUP_MASK
#define DUP_MASK 0u
#endif
    const int it_lo = 2 * P0_.ph_lo, it_hi = 2 * P0_.ph_hi;
#pragma unroll 1
    for (int it = it_lo; it < it_hi; ++it) {
        const int ph = it >> 1;
        if ((it & 1) && !((DUP_MASK >> ph) & 1u)) continue;
        int tid = threadIdx.x; asm volatile("" : "+v"(tid));
        int bid = blockIdx.x; asm volatile("" : "+s"(bid));
        int G = gridDim.x; asm volatile("" : "+s"(G));
        const CAS Params* pp_ = (const CAS Params*)__builtin_amdgcn_kernarg_segment_ptr(); asm volatile("" : "+s"(pp_)); const CAS Params& P = *pp_;
        unsigned char* ws = P.ws; asm volatile("" : "+s"(ws));
        const int lane = tid & 63, wave = __builtin_amdgcn_readfirstlane(tid >> 6);
        const int gw = bid * 8 + wave, NGW = G * 8;
        float* mod = (float*)(ws + WS_MOD); const float* cs = (const float*)(ws + WS_CS);
        bf16_t* hb = (bf16_t*)(ws + WS_H); bf16_t* yb = (bf16_t*)(ws + WS_Y); bf16_t* lat = (bf16_t*)(ws + WS_LAT);
        bf16_t* cq = (bf16_t*)(ws + WS_CQ); bf16_t* ckv = (bf16_t*)(ws + WS_CKV);
        bf16_t* qb_ = (bf16_t*)(ws + WS_Q); bf16_t* kb_ = (bf16_t*)(ws + WS_K); bf16_t* vb_ = (bf16_t*)(ws + WS_V); bf16_t* big = (bf16_t*)(ws + WS_BIG);
        int njobs = 0;
        if (ph == 2 || ph == 6 || ph == 8 || ph == 9 || ph == 11 || ph == 13 || ph == 15 || ph == 16) njobs = 1; else if (ph == 4) njobs = 2;
        if (njobs) {
#pragma unroll 1
            for (int jb = 0; jb < njobs; ++jb) {
                pg8::Gemm g; pg8::EpiGen E; E.O2 = nullptr; E.cs = cs; E.scale = 1.f;
                if (ph == 2)       { g = pg8::Gemm{hb, (const bf16_t*)(ws + W_IN), MT, LATP, DM};  E.mode = 1; E.O = lat; E.ldc = LATP; }
                else if (ph == 4 && jb == 0) { g = pg8::Gemm{cq, (const bf16_t*)(ws + W_UQ), MT, NH * DQK, QL}; E.mode = 3; E.O = qb_; E.ldc = NH * DQK; E.scale = QSCALE; }
                else if (ph == 4)  { g = pg8::Gemm{ckv, (const bf16_t*)(ws + W_UKV), MT, NH * 256, KVL}; E.mode = 4; E.O = kb_; E.O2 = vb_; E.ldc = 0; }
                else if (ph == 6)  { g = pg8::Gemm{hb, (const bf16_t*)(ws + W_O), MT, DM, DM}; E.mode = 1; E.O = yb; E.ldc = DM; }
                else if (ph == 8 || ph == 15)  { const int l = ph == 15; g = pg8::Gemm{hb, (const bf16_t*)(ws + W_UP) + (size_t)l * DM * DFF, MT, DFF, DM}; E.mode = 2; E.O = big; E.ldc = DFF; }
                else if (ph == 9 || ph == 16)  { const int l = ph == 16; g = pg8::Gemm{big, (const bf16_t*)(ws + W_DN) + (size_t)l * DM * DFF, MT, DM, DFF}; E.mode = 1; E.O = yb; E.ldc = DM; }
                else if (ph == 11) { g = pg8::Gemm{hb, (const bf16_t*)(ws + W_CIN), MT, 3 * DM, DM}; E.mode = 5; E.O = big; E.O2 = big + (size_t)MT * DM; E.ldc = DM; }
                else               { g = pg8::Gemm{hb, (const bf16_t*)(ws + W_COUT), MT, DM, DM}; E.mode = 1; E.O = yb; E.ldc = DM; }
                pg8::StaticOrder S; S.init(g.M, g.N, G, bid);
                int tidj = tid; asm volatile("" : "+v"(tidj));
                pg8::gemm_phase<pg8::EpiGen, pg8::StaticOrder, true, true>(lds, g, S, E, tidj);
                __syncthreads();
                if (ph == 2) { int tid3 = tid; asm volatile("" : "+v"(tid3)); deferred_convert(P, ws, lds, tid3 & 63, __builtin_amdgcn_readfirstlane(tid3 >> 6), G, bid); }
            }
        } else if (ph == 0) {
            p0_prologue(P, ws, lds, tid, lane, wave, G, bid);
        } else if (ph == 1) {
            row_prenorm(P.x, P.norm_g, mod, 0, 1, hb, lane, gw, NGW);
        } else if (ph == 3) {
            row_latent(lat, P.mla_g_q, P.mla_g_kv, cs, cq, ckv, kb_, lane, gw, NGW);
        } else if (ph == 5) {
            const int vcu = (G % 8 == 0) ? (bid % 8) * (G / 8) + bid / 8 : bid;
            if (G == 256) { const int bh = vcu >> 2, s = vcu & 3;
#pragma unroll 1
                for (int i = 0; i < 4; ++i) { const int qb = (i == 0) ? 15 - s : (i == 1) ? 8 + s : (i == 2) ? 7 - s : s; int tid2 = tid; asm volatile("" : "+v"(tid2)); att::attn_unit(bh >> 4, bh & 15, qb, qb_, kb_, vb_, hb, lds, tid2); } }
            else {
#pragma unroll 1
                for (int u = bid; u < NB * NH * 16; u += G) { int tid2 = tid; asm volatile("" : "+v"(tid2)); att::attn_unit((u & 63) >> 4, u & 15, 15 - (u >> 6), qb_, kb_, vb_, hb, lds, tid2); } }
        } else if (ph == 12) {
            row_conv(big + (size_t)MT * DM, big, P.conv_w, hb, lane, gw, NGW);
        } else if (ph == 7 || ph == 10 || ph == 14 || ph == 17) {
            const int layer = ph >= 14, second = (ph == 10 || ph == 17);
            const float* ng = P.norm_g + (size_t)layer * 4 * DM; const float* md = mod + (size_t)layer * 4 * NMOD;
            const float* gpost = ng + (second ? 3 : 1) * DM; const float* gate = md + (second ? 5 : 2) * DM;
            bf16_t* xb = (bf16_t*)(ws + WS_XB);
            const float* gpre; const float* sc; const float* sh; bf16_t* hout = hb;
            if (!second) { gpre = ng + 2 * DM; sc = md + 4 * DM; sh = md + 3 * DM; }
            else if (layer == 0) { gpre = P.norm_g + 4 * DM; sc = mod + (size_t)4 * NMOD + 1 * DM; sh = mod + (size_t)4 * NMOD; }
            else { gpre = gpost; sc = gate; sh = gate; hout = nullptr; }
            row_resid((ph == 7) ? P.x : nullptr, xb, yb, (ph == 17) ? P.out : nullptr, xb, hout, gpost, gate, gpre, sc, sh, lane, gw, NGW);
        }
#ifdef EXTRA_SYNCS
        if (ph == 3) { for (int e = 0; e < EXTRA_SYNCS; ++e) grid.sync(); }
#endif
        if (it + 1 < it_hi) { if (P.use_cg) grid.sync(); else xcd_barrier(xbar); }
    }
}

extern "C" void kernel_launch(void* const* d_in, const int* in_sizes, int n_in, void* d_out, int out_size, void* d_ws, size_t ws_size, hipStream_t stream) {
    static int grid = 0;
    if (grid == 0) {
        if (n_in != 17 || out_size != MT * DM || ws_size < WS_END) { fprintf(stderr, "kernel_launch: unexpected problem (n_in %d, out %d, ws %zu)\n", n_in, out_size, ws_size); grid = -1; return; }
        int dev = 0, cus = 0, per_cu = 0;
        hipGetDevice(&dev); hipDeviceGetAttribute(&cus, hipDeviceAttributeMultiprocessorCount, dev);
        if (hipFuncSetAttribute((const void*)fwd_megakernel, hipFuncAttributeMaxDynamicSharedMemorySize, LDS_BYTES) != hipSuccess) { fprintf(stderr, "kernel_launch: hipFuncSetAttribute failed\n"); grid = -1; return; }
        if (hipOccupancyMaxActiveBlocksPerMultiprocessor(&per_cu, (const void*)fwd_megakernel, NTHREADS, LDS_BYTES) != hipSuccess || per_cu < 1) { fprintf(stderr, "kernel_launch: occupancy query says %d\n", per_cu); per_cu = 1; }
        (void)hipGetLastError();
        grid = cus;
        fprintf(stderr, "kernel_launch: cus %d per_cu %d grid %d ws %zu\n", cus, per_cu, grid, ws_size);
    }
    if (grid < 0) return;
    Params p{};
    p.x = (const float*)d_in[0]; p.c = (const float*)d_in[1]; p.pos = (const int*)d_in[2]; p.w_mod = (const float*)d_in[3]; p.b_mod = (const float*)d_in[4]; p.norm_g = (const float*)d_in[5];
    p.mla_w_in = (const float*)d_in[6]; p.mla_g_q = (const float*)d_in[7]; p.mla_g_kv = (const float*)d_in[8]; p.mla_w_uq = (const float*)d_in[9]; p.mla_w_ukv = (const float*)d_in[10]; p.mla_w_o = (const float*)d_in[11];
    p.conv_w_in = (const float*)d_in[12]; p.conv_w = (const float*)d_in[13]; p.conv_w_out = (const float*)d_in[14]; p.mlp_w_up = (const float*)d_in[15]; p.mlp_w_down = (const float*)d_in[16];
    p.out = (float*)d_out; p.ws = (unsigned char*)d_ws; p.ph_lo = 0; p.ph_hi = 18; p.use_cg = 0; p.pad = 0;
    if (hipMemsetAsync(d_ws, 0, 16384, stream) != hipSuccess) { fprintf(stderr, "kernel_launch: memset failed\n"); return; }
    void* args[] = {&p};
    hipError_t e = hipLaunchCooperativeKernel((const void*)fwd_megakernel, dim3(grid), dim3(NTHREADS), args, LDS_BYTES, stream);
    if (e != hipSuccess) fprintf(stderr, "kernel_launch: cooperative launch failed: %s (grid %d)\n", hipGetErrorString(e), grid);
}
```
